# Optimizing an MI355X kernel written in HIP

```python
import math
import jax, jax.numpy as jnp
from jax import lax
import numpy as np

D_MODEL = 1024
BATCH = 2
SEQ = 8192
DEPTH = 4
DEC_BATCH = 128
DEC_SEQ = 1
PAST_LEN = 8192
PAGE_SIZE = 128

N_A = DEPTH // 2
N_B = DEPTH - N_A
CONV_W = 3
N_HEADS = 16
N_KV_HEADS = 4
HEAD_DIM = D_MODEL // N_HEADS
GROUP = N_HEADS // N_KV_HEADS
ROT_DIM = HEAD_DIM // 4
ROPE_THETA = 500000.0
WINDOW = 128
BLOCK = 128
D_FF = 2816
EPS = 1e-6
W_BUF = min(WINDOW, PAST_LEN)

kernel_name = "yoco_shortconv_swa_sink_macaron"


def _rmsnorm(x, g):
    xf = x.astype(jnp.float32)
    y = xf * lax.rsqrt(jnp.mean(xf * xf, axis=-1, keepdims=True) + EPS)
    return (y * g.astype(jnp.float32)).astype(x.dtype)


def _swiglu(h, w_gate, w_up, w_down):
    return (jax.nn.silu(h @ w_gate) * (h @ w_up)) @ w_down


def _rope(x, pos):
    half = ROT_DIM // 2
    inv_freq = ROPE_THETA ** (-jnp.arange(0, ROT_DIM, 2, dtype=jnp.float32) / ROT_DIM)
    ang = pos.astype(jnp.float32)[:, None] * inv_freq[None, :]
    cos = jnp.cos(ang)[:, None, :]
    sin = jnp.sin(ang)[:, None, :]
    xr = x[..., :ROT_DIM].astype(jnp.float32)
    x1, x2 = xr[..., :half], xr[..., half:]
    rot = jnp.concatenate([x1 * cos - x2 * sin, x2 * cos + x1 * sin], axis=-1)
    return jnp.concatenate([rot.astype(x.dtype), x[..., ROT_DIM:]], axis=-1)


def _short_conv_mixer(h, conv_state, w_in, w_conv, w_out):
    S = h.shape[1]
    b, c, u = jnp.split(h @ w_in, 3, axis=-1)
    cu = c * u
    ext = jnp.concatenate([conv_state.astype(cu.dtype), cu], axis=1)
    conv = sum(w_conv[j] * ext[:, j:j + S] for j in range(CONV_W))
    y = (b * conv) @ w_out
    return y, ext[:, -(CONV_W - 1):]


def _shared_kv(x, pos, g_kv, w_kv, g_knorm):
    B, S, _ = x.shape
    kv = _rmsnorm(x, g_kv) @ w_kv
    k, v = jnp.split(kv, 2, axis=-1)
    k = k.reshape(B, S, N_KV_HEADS, HEAD_DIM)
    v = v.reshape(B, S, N_KV_HEADS, HEAD_DIM)
    k = _rope(_rmsnorm(k, g_knorm), pos)
    return k, v


def _queries(h, pos, w_q, g_qnorm):
    B, S, _ = h.shape
    q = (h @ w_q).reshape(B, S, N_HEADS, HEAD_DIM)
    return _rope(_rmsnorm(q, g_qnorm), pos)


def _sink_weights(s, valid, sinks):
    sk = sinks.astype(jnp.float32).reshape(N_KV_HEADS, GROUP)[:, :, None, None]
    s = jnp.where(valid, s, -jnp.inf)
    m = jnp.maximum(jnp.max(s, axis=-1, keepdims=True), sk)
    p = jnp.exp(s - m)
    return p / (jnp.sum(p, axis=-1, keepdims=True) + jnp.exp(sk - m))


def _banded_window_attention(q, k, v, sinks):
    B, S, _, _ = q.shape
    nblk = S // BLOCK
    qb = q.reshape(B, nblk, BLOCK, N_KV_HEADS, GROUP, HEAD_DIM)
    kb = k.reshape(B, nblk, BLOCK, N_KV_HEADS, HEAD_DIM)
    vb = v.reshape(B, nblk, BLOCK, N_KV_HEADS, HEAD_DIM)
    kk = jnp.concatenate([jnp.concatenate([jnp.zeros_like(kb[:, :1]), kb[:, :-1]], axis=1), kb], axis=2)
    vv = jnp.concatenate([jnp.concatenate([jnp.zeros_like(vb[:, :1]), vb[:, :-1]], axis=1), vb], axis=2)
    s = jnp.einsum('bnqhgd,bnshd->bnhgqs', qb, kk).astype(jnp.float32) * (1.0 / math.sqrt(HEAD_DIM))
    qi = jnp.arange(BLOCK)[:, None] + BLOCK
    kj = jnp.arange(2 * BLOCK)[None, :]
    rel = qi - kj
    band = (rel >= 0) & (rel < WINDOW)
    kpos = (jnp.arange(nblk)[:, None, None] - 1) * BLOCK + kj[None]
    valid = (band[None] & (kpos >= 0))[None, :, None, None]
    w = _sink_weights(s, valid, sinks)
    o = jnp.einsum('bnhgqs,bnshd->bnqhgd', w.astype(v.dtype), vv)
    return o.reshape(B, S, N_HEADS * HEAD_DIM)


def _cached_window_attention(q, k_new, v_new, cache_k, cache_v, sinks):
    Bd, Sd, _, _ = q.shape
    kk = jnp.concatenate([cache_k.astype(k_new.dtype), k_new], axis=1)
    vv = jnp.concatenate([cache_v.astype(v_new.dtype), v_new], axis=1)
    qg = q.reshape(Bd, Sd, N_KV_HEADS, GROUP, HEAD_DIM)
    s = jnp.einsum('bqhgd,bshd->bhgqs', qg, kk).astype(jnp.float32) * (1.0 / math.sqrt(HEAD_DIM))
    qpos = PAST_LEN + jnp.arange(Sd)
    kpos = jnp.concatenate([PAST_LEN - W_BUF + jnp.arange(W_BUF), PAST_LEN + jnp.arange(Sd)])
    rel = qpos[:, None] - kpos[None, :]
    valid = ((rel >= 0) & (rel < WINDOW))[None, None, None]
    w = _sink_weights(s, valid, sinks)
    o = jnp.einsum('bhgqs,bshd->bqhgd', w.astype(vv.dtype), vv)
    return o.reshape(Bd, Sd, N_HEADS * HEAD_DIM)


def _trunk(x, pos, conv_in, cache_k, cache_v,
           g_ffn1, w_ffn1_gate, w_ffn1_up, w_ffn1_down, g_mix,
           g_ffn2, w_ffn2_gate, w_ffn2_up, w_ffn2_down,
           w_in_a, conv_w, w_out_a, g_kv, w_kv, g_knorm,
           w_q, g_qnorm, sinks, w_o):
    new_conv = []
    k = v = None
    for i in range(DEPTH):
        if i == N_A:
            k, v = _shared_kv(x, pos, g_kv, w_kv, g_knorm)
        x = x + 0.5 * _swiglu(_rmsnorm(x, g_ffn1[i]), w_ffn1_gate[i], w_ffn1_up[i], w_ffn1_down[i])
        h = _rmsnorm(x, g_mix[i])
        if i < N_A:
            y, st = _short_conv_mixer(h, conv_in[i], w_in_a[i], conv_w[i], w_out_a[i])
            new_conv.append(st)
        else:
            j = i - N_A
            q = _queries(h, pos, w_q[j], g_qnorm[j])
            if cache_k is None:
                o = _banded_window_attention(q, k, v, sinks[j])
            else:
                o = _cached_window_attention(q, k, v, cache_k, cache_v, sinks[j])
            y = o @ w_o[j]
        x = x + y
        x = x + 0.5 * _swiglu(_rmsnorm(x, g_ffn2[i]), w_ffn2_gate[i], w_ffn2_up[i], w_ffn2_down[i])
    if cache_k is None:
        kb, vb = k[:, -W_BUF:], v[:, -W_BUF:]
    else:
        kb = jnp.concatenate([cache_k.astype(k.dtype), k], axis=1)[:, -W_BUF:]
        vb = jnp.concatenate([cache_v.astype(v.dtype), v], axis=1)[:, -W_BUF:]
    return x, jnp.stack(new_conv), kb, vb


def setup_inputs(seed: int = 0) -> dict:
    key = jax.random.key(seed)
    ks = jax.random.split(key, 24)

    def nrm(k, shape, scale):
        return jax.random.normal(k, shape, jnp.float32) * scale

    HKV = N_KV_HEADS * HEAD_DIM
    HQ = N_HEADS * HEAD_DIM
    return {
        "x_prompt": nrm(ks[0], (BATCH, SEQ, D_MODEL), 1.0),
        "x_sample": nrm(ks[1], (DEC_BATCH, DEC_SEQ, D_MODEL), 1.0),
        "state_conv": nrm(ks[2], (N_A, DEC_BATCH, CONV_W - 1, D_MODEL), 1.0),
        "cache_k": nrm(ks[3], (DEC_BATCH, W_BUF, N_KV_HEADS, HEAD_DIM), 1.0),
        "cache_v": nrm(ks[4], (DEC_BATCH, W_BUF, N_KV_HEADS, HEAD_DIM), 1.0),
        "g_ffn1": 1.0 + nrm(ks[5], (DEPTH, D_MODEL), 0.02),
        "w_ffn1_gate": nrm(ks[6], (DEPTH, D_MODEL, D_FF), D_MODEL ** -0.5),
        "w_ffn1_up": nrm(ks[7], (DEPTH, D_MODEL, D_FF), D_MODEL ** -0.5),
        "w_ffn1_down": nrm(ks[8], (DEPTH, D_FF, D_MODEL), D_FF ** -0.5),
        "g_mix": 1.0 + nrm(ks[9], (DEPTH, D_MODEL), 0.02),
        "g_ffn2": 1.0 + nrm(ks[10], (DEPTH, D_MODEL), 0.02),
        "w_ffn2_gate": nrm(ks[11], (DEPTH, D_MODEL, D_FF), D_MODEL ** -0.5),
        "w_ffn2_up": nrm(ks[12], (DEPTH, D_MODEL, D_FF), D_MODEL ** -0.5),
        "w_ffn2_down": nrm(ks[13], (DEPTH, D_FF, D_MODEL), D_FF ** -0.5),
        "w_in_a": nrm(ks[14], (N_A, D_MODEL, 3 * D_MODEL), D_MODEL ** -0.5),
        "conv_w": nrm(ks[15], (N_A, CONV_W, D_MODEL), CONV_W ** -0.5),
        "w_out_a": nrm(ks[16], (N_A, D_MODEL, D_MODEL), D_MODEL ** -0.5),
        "g_kv": 1.0 + nrm(ks[17], (D_MODEL,), 0.02),
        "w_kv": nrm(ks[18], (D_MODEL, 2 * HKV), D_MODEL ** -0.5),
        "g_knorm": 1.0 + nrm(ks[19], (HEAD_DIM,), 0.02),
        "w_q": nrm(ks[20], (N_B, D_MODEL, HQ), D_MODEL ** -0.5),
        "g_qnorm": 1.0 + nrm(ks[21], (N_B, HEAD_DIM), 0.02),
        "sinks": nrm(ks[22], (N_B, N_HEADS), 1.0),
        "w_o": nrm(ks[23], (N_B, HQ, D_MODEL), HQ ** -0.5),
    }


def reference(x_prompt, x_sample, state_conv, cache_k, cache_v,
              g_ffn1, w_ffn1_gate, w_ffn1_up, w_ffn1_down, g_mix,
              g_ffn2, w_ffn2_gate, w_ffn2_up, w_ffn2_down,
              w_in_a, conv_w, w_out_a, g_kv, w_kv, g_knorm,
              w_q, g_qnorm, sinks, w_o):
    weights = (g_ffn1, w_ffn1_gate, w_ffn1_up, w_ffn1_down, g_mix,
               g_ffn2, w_ffn2_gate, w_ffn2_up, w_ffn2_down,
               w_in_a, conv_w, w_out_a, g_kv, w_kv, g_knorm,
               w_q, g_qnorm, sinks, w_o)
    pos_p = jnp.arange(SEQ, dtype=jnp.int32)
    conv0 = jnp.zeros((N_A, x_prompt.shape[0], CONV_W - 1, D_MODEL), x_prompt.dtype)
    y_prompt, conv_p, k_p, v_p = _trunk(x_prompt, pos_p, conv0, None, None, *weights)
    pos_s = PAST_LEN + jnp.arange(x_sample.shape[1], dtype=jnp.int32)
    y_sample, conv_s, k_s, v_s = _trunk(x_sample, pos_s, state_conv, cache_k, cache_v, *weights)
    return (y_prompt, y_sample, conv_p, k_p, v_p, conv_s, k_s, v_s)
```

```cpp
#include <hip/hip_runtime.h>
#include <hip/hip_cooperative_groups.h>
#include <cstdio>
#include <cstdint>
namespace cg = cooperative_groups;
#define N_LAUNCH_PER_PHASE 0
namespace pg8 {
#define PG8_LAS __attribute__((address_space(3)))
typedef unsigned short bf16_t;
typedef short bf16x8 __attribute__((ext_vector_type(8)));
typedef float f32x4 __attribute__((ext_vector_type(4)));
typedef unsigned u32x4 __attribute__((ext_vector_type(4)));
constexpr int BM = 256, BK = 64, HALF = 128, HTB = HALF * BK * 2  , STAGE_BYTES = 8 * HTB, NXCD = 8, WGM = 8;

__host__ __device__ __forceinline__ int lds_byte(int r, int c) { const int st = (r >> 4) * 2 + (c >> 5), rr = r & 15, cc = c & 31, ob = rr * 64 + cc * 2; return st * 1024 + (ob ^ (((ob >> 9) & 1) << 5)); }
__host__ __device__ __forceinline__ void stage_rc(int b, int& R, int& C) { const int st = b / 1024, sb = b % 1024, swz = sb ^ (((sb >> 9) & 1) << 5); R = (st >> 1) * 16 + swz / 64; C = (st & 1) * 32 + (swz % 64) / 2; }
__host__ __device__ __forceinline__ int perm32(int rho) { const int n = rho >> 4, i = rho & 15; return 8 * (i >> 2) + 4 * n + (i & 3); }

struct Unit { int pm, pn; };
struct Gemm { const bf16_t* A; const bf16_t* Bt; int M, N, K; };

struct StaticOrder {
    int nM, nN, nwg, G, c;
    __host__ __device__ void init(int M, int N, int G_, int c_) { nM = M / BM; nN = N / BM; nwg = nM * nN; G = G_; c = c_; }
    __host__ __device__ bool next(int i, Unit& u) const {
        const long L = (long)i * G + c; if (L >= nwg) return false;
        int wgid = (int)L; { const int q = nwg / NXCD, r = nwg % NXCD, xcd = wgid % NXCD, off = wgid / NXCD; wgid = (xcd < r ? xcd * (q + 1) : r * (q + 1) + (xcd - r) * q) + off; }
        const int nig = WGM * nN, gid = wgid / nig, fm = gid * WGM, gsz = (nM - fm) < WGM ? (nM - fm) : WGM;
        u.pm = fm + ((wgid % nig) % gsz); u.pn = (wgid % nig) / gsz; return true;
    }
    __device__ __forceinline__ void a_ready(const Unit&) const {}
    __device__ __forceinline__ void done(const Unit&) const {}
};

__device__ __forceinline__ unsigned cvt_pk_bf16(float lo, float hi) { unsigned r; asm volatile("v_cvt_pk_bf16_f32 %0, %1, %2" : "=v"(r) : "v"(lo), "v"(hi)); return r; }
typedef unsigned u32x2 __attribute__((ext_vector_type(2)));
constexpr int ROWS_REAL = 16512, ROWS_PROMPT = 16384, DM = 1024, DFF = 2816;
__device__ __forceinline__ float row_rstd(const float* ssq, int row) { return __builtin_amdgcn_rsqf(ssq[row] * (1.0f / 1024.0f) + 1e-6f); }
__device__ __forceinline__ float silu_mul(float g, float u) { return g * __builtin_amdgcn_rcpf(1.0f + __expf(-g)) * u; }

struct EpiSwiGLU {
    static constexpr bool PERM = true, AFTER_DRAIN = false;
    bf16_t* H; const float* ssq;
    __device__ __forceinline__ void operator()(const f32x4 (&acc)[2][2][4][2], const Unit& u, int wr, int wc, int fr, int fq) const {
        const int row0 = u.pm * BM + wr * 64 + fr, col0 = u.pn * 128 + wc * 32 + 8 * fq;
#pragma unroll
        for (int ai = 0; ai < 2; ++ai)
#pragma unroll
            for (int m = 0; m < 4; ++m) {
                const int row = row0 + ai * HALF + m * 16; const float r = row_rstd(ssq, row);
                const f32x4 g0 = acc[ai][0][m][0] * r, g1 = acc[ai][0][m][1] * r, u0 = acc[ai][1][m][0] * r, u1 = acc[ai][1][m][1] * r;
                u32x4 w;
                w.x = cvt_pk_bf16(silu_mul(g0[0], u0[0]), silu_mul(g0[1], u0[1])); w.y = cvt_pk_bf16(silu_mul(g0[2], u0[2]), silu_mul(g0[3], u0[3]));
                w.z = cvt_pk_bf16(silu_mul(g1[0], u1[0]), silu_mul(g1[1], u1[1])); w.w = cvt_pk_bf16(silu_mul(g1[2], u1[2]), silu_mul(g1[3], u1[3]));
                *(u32x4*)(H + (size_t)row * DFF + col0) = w;
            }
    }
};

struct EpiResid {
    static constexpr bool PERM = false, AFTER_DRAIN = false;
    float* X; bf16_t* XB; float* ssq_next; float scale;
    __device__ __forceinline__ void operator()(const f32x4 (&acc)[2][2][4][2], const Unit& u, int wr, int wc, int fr, int fq) const {
        const int row0 = u.pm * BM + wr * 64 + fr, col0 = u.pn * BM + wc * 32 + 4 * fq;
#pragma unroll
        for (int ai = 0; ai < 2; ++ai) {
            if (u.pm * BM + ai * HALF >= ROWS_REAL) continue;
#pragma unroll
            for (int m = 0; m < 4; ++m) {
                const int row = row0 + ai * HALF + m * 16; float ss = 0.f;
#pragma unroll
                for (int bj = 0; bj < 2; ++bj)
#pragma unroll
                    for (int n = 0; n < 2; ++n) {
                        const size_t off = (size_t)row * DM + col0 + bj * HALF + n * 16;
                        f32x4 x = *(const f32x4*)(X + off); x = x + acc[ai][bj][m][n] * scale; *(f32x4*)(X + off) = x;
                        u32x2 w; w.x = cvt_pk_bf16(x[0], x[1]); w.y = cvt_pk_bf16(x[2], x[3]); *(u32x2*)(XB + off) = w;
                        ss += (x[0] * x[0] + x[1] * x[1]) + (x[2] * x[2] + x[3] * x[3]);
                    }
                ss += __shfl_xor(ss, 16); ss += __shfl_xor(ss, 32);
                if (fq == 0) __hip_atomic_fetch_add(ssq_next + row, ss, __ATOMIC_RELAXED, __HIP_MEMORY_SCOPE_AGENT);
            }
        }
    }
};

struct EpiInProj {
    static constexpr bool PERM = true, AFTER_DRAIN = false;
    bf16_t* CU; bf16_t* BZ; const float* ssq;
    __device__ __forceinline__ void operator()(const f32x4 (&acc)[2][2][4][2], const Unit& u, int wr, int wc, int fr, int fq) const {
        const int row0 = u.pm * BM + wr * 64 + fr;
#pragma unroll
        for (int ai = 0; ai < 2; ++ai)
#pragma unroll
            for (int m = 0; m < 4; ++m) {
                const int row = row0 + ai * HALF + m * 16; const float r = row_rstd(ssq, row);
                if (u.pn < 8) {
                    const float r2 = r * r; const f32x4 p0 = acc[ai][0][m][0] * acc[ai][1][m][0] * r2, p1 = acc[ai][0][m][1] * acc[ai][1][m][1] * r2;
                    u32x4 w; w.x = cvt_pk_bf16(p0[0], p0[1]); w.y = cvt_pk_bf16(p0[2], p0[3]); w.z = cvt_pk_bf16(p1[0], p1[1]); w.w = cvt_pk_bf16(p1[2], p1[3]);
                    *(u32x4*)(CU + (size_t)row * DM + u.pn * 128 + wc * 32 + 8 * fq) = w;
                } else {
#pragma unroll
                    for (int bj = 0; bj < 2; ++bj) {
                        const f32x4 p0 = acc[ai][bj][m][0] * r, p1 = acc[ai][bj][m][1] * r;
                        u32x4 w; w.x = cvt_pk_bf16(p0[0], p0[1]); w.y = cvt_pk_bf16(p0[2], p0[3]); w.z = cvt_pk_bf16(p1[0], p1[1]); w.w = cvt_pk_bf16(p1[2], p1[3]);
                        *(u32x4*)(BZ + (size_t)row * DM + (u.pn - 8) * BM + bj * HALF + wc * 32 + 8 * fq) = w;
                    }
                }
            }
    }
};

__device__ __forceinline__ void head_norm_rope(f32x4 (&v)[2][2], const f32x4 (&g)[2][2], int pos, int fq) {
    float ss = 0.f;
#pragma unroll
    for (int bj = 0; bj < 2; ++bj)
#pragma unroll
        for (int n = 0; n < 2; ++n) ss += (v[bj][n][0] * v[bj][n][0] + v[bj][n][1] * v[bj][n][1]) + (v[bj][n][2] * v[bj][n][2] + v[bj][n][3] * v[bj][n][3]);
    ss += __shfl_xor(ss, 16); ss += __shfl_xor(ss, 32);
    const float hr = __builtin_amdgcn_rsqf(ss * (1.0f / 64.0f) + 1e-6f);
#pragma unroll
    for (int bj = 0; bj < 2; ++bj)
#pragma unroll
        for (int n = 0; n < 2; ++n) v[bj][n] = v[bj][n] * hr * g[bj][n];
    const f32x4 x = v[0][0]; f32x4 o;
    const bool lo = (fq & 1) == 0;
    const float f0 = lo ? 1.0f : 0.001414213562373095f, f1 = lo ? 0.19392274474868576f : 0.0002742481756762073f;
    const float f2 = lo ? 0.03760603093086393f : 5.318295896944988e-05f, f3 = lo ? 0.007292664737217109f : 1.031338537721246e-05f;
    const float fr4[4] = {f0, f1, f2, f3};
#pragma unroll
    for (int e = 0; e < 4; ++e) {
        const float partner = __shfl_xor(x[e], 32);
        const float ang = (float)pos * fr4[e];
        double rev = (double)ang * 0.15915494309189535; rev -= __builtin_floor(rev);
        const float rv = (float)rev; const float s = __builtin_amdgcn_sinf(rv), c = __builtin_amdgcn_cosf(rv);
        o[e] = (fq < 2) ? (x[e] * c - partner * s) : (x[e] * c + partner * s);
    }
    v[0][0] = o;
}
__device__ __forceinline__ int row_pos(int row) { return row < ROWS_PROMPT ? (row & 8191) : 8192; }

struct EpiQ {
    static constexpr bool PERM = false, AFTER_DRAIN = false;
    bf16_t* Qb; const float* ssq; const float* gq;
    __device__ __forceinline__ void operator()(const f32x4 (&acc)[2][2][4][2], const Unit& u, int wr, int wc, int fr, int fq) const {
        const int row0 = u.pm * BM + wr * 64 + fr; const int colh = u.pn * BM + 64 * wc + 4 * fq;
        f32x4 g[2][2];
#pragma unroll
        for (int bj = 0; bj < 2; ++bj)
#pragma unroll
            for (int n = 0; n < 2; ++n) g[bj][n] = *(const f32x4*)(gq + 32 * bj + 16 * n + 4 * fq);
#pragma unroll
        for (int ai = 0; ai < 2; ++ai)
#pragma unroll
            for (int m = 0; m < 4; ++m) {
                const int row = row0 + ai * HALF + m * 16; const float r = row_rstd(ssq, row);
                f32x4 v[2][2];
#pragma unroll
                for (int bj = 0; bj < 2; ++bj)
#pragma unroll
                    for (int n = 0; n < 2; ++n) v[bj][n] = acc[ai][bj][m][n] * r;
                head_norm_rope(v, g, row_pos(row), fq);
#pragma unroll
                for (int bj = 0; bj < 2; ++bj)
#pragma unroll
                    for (int n = 0; n < 2; ++n) { const f32x4 x = v[bj][n] * 0.125f; u32x2 w; w.x = cvt_pk_bf16(x[0], x[1]); w.y = cvt_pk_bf16(x[2], x[3]);
                        *(u32x2*)(Qb + (size_t)row * DM + colh + 32 * bj + 16 * n) = w; }
            }
    }
};

struct EpiKV {
    static constexpr bool PERM = false, AFTER_DRAIN = false;
    bf16_t* Kb; bf16_t* Vt; const float* ssq; const float* gk; float* ckp; float* cvp; float* cks; float* cvs;
    __device__ __forceinline__ void operator()(const f32x4 (&acc)[2][2][4][2], const Unit& u, int wr, int wc, int fr, int fq) const {
        const int row0 = u.pm * BM + wr * 64 + fr; const int colh = 64 * wc + 4 * fq; const bool isk = (u.pn == 0);
        f32x4 g[2][2];
#pragma unroll
        for (int bj = 0; bj < 2; ++bj)
#pragma unroll
            for (int n = 0; n < 2; ++n) g[bj][n] = *(const f32x4*)(gk + 32 * bj + 16 * n + 4 * fq);
#pragma unroll
        for (int ai = 0; ai < 2; ++ai) {
            if (u.pm * BM + ai * HALF >= ROWS_REAL) continue;
#pragma unroll
            for (int m = 0; m < 4; ++m) {
                const int row = row0 + ai * HALF + m * 16; const float r = row_rstd(ssq, row);
                f32x4 v[2][2];
#pragma unroll
                for (int bj = 0; bj < 2; ++bj)
#pragma unroll
                    for (int n = 0; n < 2; ++n) v[bj][n] = acc[ai][bj][m][n] * r;
                if (isk) head_norm_rope(v, g, row_pos(row), fq);
                float* cache = nullptr;
                if (row >= ROWS_PROMPT) cache = (isk ? cks : cvs) + ((size_t)(row - ROWS_PROMPT) * 128 + 127) * 256;
                else { const int t = row & 8191, b = row >> 13; if (t >= 8192 - 128) cache = (isk ? ckp : cvp) + ((size_t)b * 128 + (t - (8192 - 128))) * 256; }
#pragma unroll
                for (int bj = 0; bj < 2; ++bj)
#pragma unroll
                    for (int n = 0; n < 2; ++n) {
                        const f32x4 x = v[bj][n]; const int c = colh + 32 * bj + 16 * n;
                        if (cache) *(f32x4*)(cache + c) = x;
                        if (row < ROWS_PROMPT) {
                            if (isk) { u32x2 w; w.x = cvt_pk_bf16(x[0], x[1]); w.y = cvt_pk_bf16(x[2], x[3]); *(u32x2*)(Kb + (size_t)row * 256 + c) = w; }
                            else { const int t = row & 8191, b = row >> 13; const int d = 4 * fq + 32 * bj + 16 * n;
                                bf16_t* vp = Vt + ((size_t)(b * 4 + wc) * 64 + d) * 8192 + t;
                                const unsigned w0 = cvt_pk_bf16(x[0], x[1]), w1 = cvt_pk_bf16(x[2], x[3]);
                                vp[0] = (bf16_t)(w0 & 0xffffu); vp[8192] = (bf16_t)(w0 >> 16); vp[2 * 8192] = (bf16_t)(w1 & 0xffffu); vp[3 * 8192] = (bf16_t)(w1 >> 16); }
                        }
                    }
            }
        }
    }
};
template <class Epi, class Sched, bool ALIGN_EPI = false, bool SP2 = false>
__device__ __forceinline__ void gemm_phase(const int tid, PG8_LAS unsigned char* lds, const Gemm g, const Sched& S, const Epi& E) {
    const int wid = __builtin_amdgcn_readfirstlane(tid >> 6), lane = tid & 63, wr = wid >> 2, wc = wid & 3, fr = lane & 15, fq = lane >> 4;
    const int K = g.K, nt = K / BK;
    unsigned voffA[2], voffB[2];
#pragma unroll
    for (int i = 0; i < 2; ++i) { int R, C; stage_rc(tid * 16 + i * 8192, R, C); const int Rb = Epi::PERM ? ((R & ~31) + perm32(R & 31)) : R;
        voffA[i] = (unsigned)(R * K + C) * 2u; voffB[i] = (unsigned)(Rb * K + C) * 2u; }
    const size_t kstep = (size_t)(BK * 2);
    const size_t hstep = (size_t)HALF * K * 2;
    const size_t tstep = 2 * hstep;
    const unsigned ldsw = (unsigned)wid * 1024u;
    const int aoff = lds_byte(wr * 64 + fr, fq * 8), boff = lds_byte(wc * 32 + fr, fq * 8);
#define PG8_SA(b, h) (((b) * 2 + (h)) * HTB)
#define PG8_SB(b, h) ((4 + (b) * 2 + (h)) * HTB)
#define PG8_STAGE(bufoff, gbase, voff) do { _Pragma("unroll") for (int _i = 0; _i < 2; ++_i) \
        __builtin_amdgcn_global_load_lds((const unsigned*)((const char*)(gbase) + (voff)[_i]), (PG8_LAS unsigned*)(lds + (bufoff) + ldsw + _i * 8192), 16, 0, 0); } while (0)
#define PG8_LDA(dst, b, h) do { _Pragma("unroll") for (int m = 0; m < 4; ++m) _Pragma("unroll") for (int k = 0; k < 2; ++k) dst[m][k] = *(const PG8_LAS bf16x8*)(lds + PG8_SA(b, h) + aoff + m * 2048 + k * 1024); } while (0)
#define PG8_LDB(dst, b, h) do { _Pragma("unroll") for (int n = 0; n < 2; ++n) _Pragma("unroll") for (int k = 0; k < 2; ++k) dst[n][k] = *(const PG8_LAS bf16x8*)(lds + PG8_SB(b, h) + boff + n * 2048 + k * 1024); } while (0)
#define PG8_MMA(ai, bj, At, Bt) do { __builtin_amdgcn_s_setprio(1); _Pragma("unroll") for (int m = 0; m < 4; ++m) _Pragma("unroll") for (int n = 0; n < 2; ++n) _Pragma("unroll") for (int k = 0; k < 2; ++k) \
        acc[ai][bj][m][n] = __builtin_amdgcn_mfma_f32_16x16x32_bf16(Bt[n][k], At[m][k], acc[ai][bj][m][n], 0, 0, 0); __builtin_amdgcn_s_setprio(0); } while (0)
#define PG8_WAIT_V(n) asm volatile("s_waitcnt vmcnt(" #n ")" ::: "memory")
#define PG8_WAIT_L(n) asm volatile("s_waitcnt lgkmcnt(" #n ")" ::: "memory")
#define PG8_BAR __builtin_amdgcn_s_barrier()
#define PG8_SCHED __builtin_amdgcn_sched_barrier(0)
    Unit cur, nxt; int ui = 0;
    if (!S.next(0, cur)) return;
    f32x4 acc[2][2][4][2];
#pragma unroll
    for (int a = 0; a < 2; ++a)
#pragma unroll
        for (int b = 0; b < 2; ++b)
#pragma unroll
            for (int m = 0; m < 4; ++m)
#pragma unroll
                for (int n = 0; n < 2; ++n) acc[a][b][m][n] = (f32x4){0.f, 0.f, 0.f, 0.f};
    bf16x8 At[4][2], B0[2][2], B1[2][2];
    const char* cA = (const char*)g.A + (size_t)cur.pm * tstep; const char* cB = (const char*)g.Bt + (size_t)cur.pn * tstep;
    S.a_ready(cur);
    if constexpr (SP2) {
        PG8_STAGE(PG8_SB(0, 0), cB, voffB); PG8_STAGE(PG8_SB(0, 1), cB + hstep, voffB); PG8_STAGE(PG8_SA(0, 0), cA, voffA); PG8_STAGE(PG8_SA(0, 1), cA + hstep, voffA);
        if (wr == 1) PG8_BAR;
        PG8_WAIT_V(2); PG8_BAR;
        PG8_STAGE(PG8_SB(1, 0), cB + kstep, voffB); PG8_STAGE(PG8_SA(1, 0), cA + kstep, voffA); PG8_STAGE(PG8_SB(1, 1), cB + hstep + kstep, voffB);
        PG8_WAIT_V(6); PG8_BAR;
    } else {
        PG8_STAGE(PG8_SB(0, 0), cB, voffB); PG8_STAGE(PG8_SA(0, 0), cA, voffA); PG8_STAGE(PG8_SB(0, 1), cB + hstep, voffB); PG8_STAGE(PG8_SA(0, 1), cA + hstep, voffA);
        if (wr == 1) PG8_BAR;
        PG8_WAIT_V(4); PG8_BAR;
        PG8_STAGE(PG8_SB(1, 0), cB + kstep, voffB); PG8_STAGE(PG8_SA(1, 0), cA + kstep, voffA); PG8_STAGE(PG8_SB(1, 1), cB + hstep + kstep, voffB);
        PG8_WAIT_V(6); PG8_BAR;
    }
    for (;;) {
        const bool has_next = S.next(ui + 1, nxt);
        const char* nA = has_next ? (const char*)g.A + (size_t)nxt.pm * tstep : cA; const char* nB = has_next ? (const char*)g.Bt + (size_t)nxt.pn * tstep : cB;
        for (int t = 0; t < nt; t += 2) {
            const bool last = (t == nt - 2);
            const char* a1 = cA + (size_t)(t + 1) * kstep;
            const char* a2 = last ? nA : cA + (size_t)(t + 2) * kstep; const char* b2 = last ? nB : cB + (size_t)(t + 2) * kstep;
            const char* a3 = a2 + kstep; const char* b3 = b2 + kstep;
            if (last && has_next) S.a_ready(nxt);
            if constexpr (SP2) {
            PG8_LDB(B0, 0, 0); PG8_LDB(B1, 0, 1); PG8_SCHED; PG8_LDA(At, 0, 0); PG8_STAGE(PG8_SA(1, 1), a1 + hstep, voffA);
            PG8_WAIT_V(8); PG8_WAIT_L(0); PG8_BAR; PG8_MMA(0, 0, At, B0); PG8_MMA(0, 1, At, B1); PG8_BAR; PG8_SCHED;
            PG8_LDA(At, 0, 1); PG8_STAGE(PG8_SB(0, 0), b2, voffB); PG8_STAGE(PG8_SB(0, 1), b2 + hstep, voffB); PG8_STAGE(PG8_SA(0, 0), a2, voffA);
            PG8_WAIT_V(8); PG8_WAIT_L(0); PG8_BAR; PG8_MMA(1, 0, At, B0); PG8_MMA(1, 1, At, B1); PG8_BAR; PG8_SCHED;
            PG8_LDB(B0, 1, 0); PG8_LDB(B1, 1, 1); PG8_SCHED; PG8_LDA(At, 1, 0); PG8_STAGE(PG8_SA(0, 1), a2 + hstep, voffA);
            PG8_WAIT_V(8); PG8_WAIT_L(0); PG8_BAR; PG8_MMA(0, 0, At, B0); PG8_MMA(0, 1, At, B1); PG8_BAR; PG8_SCHED;
            PG8_LDA(At, 1, 1); PG8_STAGE(PG8_SB(1, 0), b3, voffB); PG8_STAGE(PG8_SB(1, 1), b3 + hstep, voffB); PG8_STAGE(PG8_SA(1, 0), a3, voffA);
            PG8_WAIT_V(8); PG8_WAIT_L(0); PG8_BAR; PG8_MMA(1, 0, At, B0); PG8_MMA(1, 1, At, B1); PG8_BAR; PG8_SCHED;
            } else {
            PG8_LDB(B0, 0, 0); PG8_SCHED; PG8_LDA(At, 0, 0); PG8_STAGE(PG8_SA(1, 1), a1 + hstep, voffA);
            PG8_WAIT_L(8); PG8_BAR; PG8_WAIT_L(0); PG8_MMA(0, 0, At, B0); PG8_BAR; PG8_SCHED;
            PG8_LDB(B1, 0, 1); PG8_STAGE(PG8_SB(0, 0), b2, voffB);
            PG8_BAR; PG8_WAIT_L(0); PG8_MMA(0, 1, At, B1); PG8_BAR;
            PG8_LDA(At, 0, 1); PG8_STAGE(PG8_SA(0, 0), a2, voffA);
            PG8_BAR; PG8_WAIT_L(0); PG8_MMA(1, 0, At, B0); PG8_BAR; PG8_SCHED;
            PG8_STAGE(PG8_SB(0, 1), b2 + hstep, voffB);
            PG8_WAIT_V(6); PG8_BAR; PG8_MMA(1, 1, At, B1); PG8_BAR;
            PG8_LDB(B0, 1, 0); PG8_SCHED; PG8_LDA(At, 1, 0); PG8_STAGE(PG8_SA(0, 1), a2 + hstep, voffA);
            PG8_WAIT_L(8); PG8_BAR; PG8_WAIT_L(0); PG8_MMA(0, 0, At, B0); PG8_BAR; PG8_SCHED;
            PG8_LDB(B1, 1, 1); PG8_STAGE(PG8_SB(1, 0), b3, voffB);
            PG8_BAR; PG8_WAIT_L(0); PG8_MMA(0, 1, At, B1); PG8_BAR;
            PG8_LDA(At, 1, 1); PG8_STAGE(PG8_SA(1, 0), a3, voffA);
            PG8_BAR; PG8_WAIT_L(0); PG8_MMA(1, 0, At, B0); PG8_BAR; PG8_SCHED;
            PG8_STAGE(PG8_SB(1, 1), b3 + hstep, voffB);
            PG8_WAIT_V(6); PG8_BAR; PG8_MMA(1, 1, At, B1); PG8_BAR;
            }
        }
        if constexpr (ALIGN_EPI) { if (wr == 0) PG8_BAR; }
        if constexpr (!Epi::AFTER_DRAIN) { E(acc, cur, wr, wc, fr, fq); S.done(cur); }
        if (!has_next) break;
#pragma unroll
        for (int a = 0; a < 2; ++a)
#pragma unroll
            for (int b = 0; b < 2; ++b)
#pragma unroll
                for (int m = 0; m < 4; ++m)
#pragma unroll
                    for (int n = 0; n < 2; ++n) acc[a][b][m][n] = (f32x4){0.f, 0.f, 0.f, 0.f};
        cur = nxt; cA = nA; cB = nB; ++ui;
        if constexpr (ALIGN_EPI) { if (wr == 1) PG8_BAR; }
    }
    PG8_WAIT_V(0);
    if constexpr (!ALIGN_EPI) { if (wr == 0) PG8_BAR; }
    PG8_BAR;
    if constexpr (Epi::AFTER_DRAIN) { E.fused(acc, cur, wr, wc, fr, fq, lds, wid, lane); S.done(cur); }
#undef PG8_SA
#undef PG8_SB
#undef PG8_STAGE
#undef PG8_LDA
#undef PG8_LDB
#undef PG8_MMA
#undef PG8_WAIT_V
#undef PG8_WAIT_L
#undef PG8_BAR
#undef PG8_SCHED
}
}
#define LAS __attribute__((address_space(3)))
typedef unsigned short bf16;
typedef float f32x4 __attribute__((ext_vector_type(4)));
typedef unsigned u32x4 __attribute__((ext_vector_type(4)));
typedef unsigned u32x2 __attribute__((ext_vector_type(2)));
typedef short bf16x8 __attribute__((ext_vector_type(8)));
typedef short s16x4 __attribute__((ext_vector_type(4)));
#define LDS_WAIT() asm volatile("s_waitcnt lgkmcnt(0)" ::: "memory")

constexpr int D = 1024, FF = 2816, SEQ = 8192, MP = 16384, NSMP = 128, MR = 16512, MPAD = 16640;
constexpr int NWAVES = 8, NTHREADS = 512, LDS_BYTES = 147456;
#ifndef N_LAUNCH_PER_PHASE
#define N_LAUNCH_PER_PHASE 0
#endif
enum { I_XP = 0, I_XS, I_SCONV, I_CK, I_CV, I_GF1, I_W1G, I_W1U, I_W1D, I_GMIX, I_GF2, I_W2G, I_W2U, I_W2D, I_WINA, I_CONVW, I_WOUTA, I_GKV, I_WKV, I_GKN, I_WQ, I_GQN, I_SINKS, I_WO, N_IN };
constexpr size_t O_YP = 0, O_YS = 16777216, O_CONVP = 16908288, O_KP = 16916480, O_VP = 16982016, O_CONVS = 17047552, O_KS = 17571840, O_VS = 21766144, O_END = 25960448;
constexpr size_t MiB = 1u << 20;
constexpr size_t WS_SSQ = 0;
constexpr size_t SZ_WGU = (size_t)2 * FF * D * 2, SZ_WD = (size_t)D * FF * 2;
constexpr size_t WS_WGU = 1 * MiB;
constexpr size_t WS_WD = WS_WGU + 8 * SZ_WGU;
constexpr size_t WS_WIN = WS_WD + 8 * SZ_WD;
constexpr size_t WS_WOUT = WS_WIN + 2 * (size_t)3 * D * D * 2;
constexpr size_t WS_WKV = WS_WOUT + 2 * (size_t)D * D * 2;
constexpr size_t WS_WQ = WS_WKV + (size_t)512 * D * 2;
constexpr size_t WS_WO = WS_WQ + 2 * (size_t)D * D * 2;
constexpr size_t WS_XB = WS_WO + 2 * (size_t)D * D * 2;
constexpr size_t SZ_ACT = (size_t)MPAD * D * 2;
constexpr size_t WS_H = WS_XB + SZ_ACT;
constexpr size_t WS_KB = WS_H + (size_t)MPAD * FF * 2;
constexpr size_t WS_VT = WS_KB + (size_t)MP * 256 * 2;
constexpr size_t WS_END = WS_VT + (size_t)MP * 256 * 2;
static_assert(2 * SZ_ACT <= (size_t)MPAD * FF * 2, "overlays fit in H");

struct Args { const float* in[N_IN]; float* out; unsigned char* ws; int ph_lo, ph_hi; };
typedef const __attribute__((address_space(4))) Args* ArgsP;

__device__ __forceinline__ unsigned f2bf(float f) { unsigned u = __builtin_bit_cast(unsigned, f); return (u + 0x7fffu + ((u >> 16) & 1u)) >> 16; }
__device__ __forceinline__ unsigned pk2(float lo, float hi) { return f2bf(lo) | (f2bf(hi) << 16); }
__device__ __forceinline__ float bf2f(unsigned short b) { return __builtin_bit_cast(float, (unsigned)b << 16); }
__device__ __forceinline__ float bflo(unsigned w) { return __builtin_bit_cast(float, w << 16); }
__device__ __forceinline__ float bfhi(unsigned w) { return __builtin_bit_cast(float, w & 0xffff0000u); }
__device__ __forceinline__ float wave_sum(float v) {
#pragma unroll
    for (int o = 1; o < 64; o <<= 1) v += __shfl_xor(v, o);
    return v;
}
__device__ __forceinline__ float wave_max(float v) {
#pragma unroll
    for (int o = 1; o < 64; o <<= 1) v = fmaxf(v, __shfl_xor(v, o));
    return v;
}

__device__ __forceinline__ int rowmap(int mode, int n) {
    if (mode == 0) return n;
    if (mode == 1) return ((n >> 7) << 8) + (n & 127);
    if (mode == 2) return ((n >> 7) << 8) + 128 + (n & 127);
    if (mode == 3) {
        if (n < 1024) return 2048 + n;
        const int j = (n - 1024) & 1023; return ((j >> 7) << 8) + ((n >= 2048) ? 128 : 0) + (j & 127);
    }
    return (n & ~255) + (((n & 63) >> 5) << 7) + (((n >> 6) & 3) << 5) + (n & 31);
}
struct Job { const float* src; bf16* dst; const float* g; int K, N, mode; };
__device__ __forceinline__ Job get_job(ArgsP a, int j) {
    Job J; unsigned char* ws = a->ws;
    if (j < 24) {
        const int l = j / 6, r = j % 6, f = r / 3, t = r % 3;
        if (t < 2) { J.src = a->in[(f ? I_W2G : I_W1G) + t] + (size_t)l * D * FF; J.K = D; J.N = FF; J.dst = (bf16*)(ws + WS_WGU + (size_t)(2 * l + f) * SZ_WGU);
            J.g = a->in[f ? I_GF2 : I_GF1] + l * D; J.mode = 1 + t; }
        else { J.src = a->in[f ? I_W2D : I_W1D] + (size_t)l * FF * D; J.K = FF; J.N = D; J.dst = (bf16*)(ws + WS_WD + (size_t)(2 * l + f) * SZ_WD); J.g = nullptr; J.mode = 0; }
    } else if (j < 28) {
        const int i = (j - 24) >> 1, t = (j - 24) & 1;
        if (t == 0) { J.src = a->in[I_WINA] + (size_t)i * D * 3 * D; J.K = D; J.N = 3 * D; J.dst = (bf16*)(ws + WS_WIN + (size_t)i * 3 * D * D * 2); J.g = a->in[I_GMIX] + i * D; J.mode = 3; }
        else { J.src = a->in[I_WOUTA] + (size_t)i * D * D; J.K = D; J.N = D; J.dst = (bf16*)(ws + WS_WOUT + (size_t)i * D * D * 2); J.g = nullptr; J.mode = 0; }
    } else if (j == 28) {
        J.src = a->in[I_WKV]; J.K = D; J.N = 512; J.dst = (bf16*)(ws + WS_WKV); J.g = a->in[I_GKV]; J.mode = 4;
    } else {
        const int i = (j - 29) >> 1, t = (j - 29) & 1;
        if (t == 0) { J.src = a->in[I_WQ] + (size_t)i * D * D; J.K = D; J.N = D; J.dst = (bf16*)(ws + WS_WQ + (size_t)i * D * D * 2); J.g = a->in[I_GMIX] + (2 + i) * D; J.mode = 4; }
        else { J.src = a->in[I_WO] + (size_t)i * D * D; J.K = D; J.N = D; J.dst = (bf16*)(ws + WS_WO + (size_t)i * D * D * 2); J.g = nullptr; J.mode = 0; }
    }
    return J;
}
constexpr int NJOBS = 33;
__device__ __forceinline__ void transpose_item(const Job& J, LAS float* scr, int item, int lane) {
    const int nblk = J.N / 32, kb = item / nblk, nb = item % nblk, k0 = 64 * kb, n0 = 32 * nb;
#pragma unroll 8
    for (int i = 0; i < 32; ++i) { const int kk = 2 * i + (lane >> 5); float w = J.src[(size_t)(k0 + kk) * J.N + n0 + (lane & 31)]; if (J.g) w *= J.g[k0 + kk]; scr[kk * 33 + (lane & 31)] = w; }
    LDS_WAIT();
    const int c = lane & 7;
#pragma unroll
    for (int j = 0; j < 4; ++j) { const int n = (lane >> 3) + 8 * j; const LAS float* s = scr + (8 * c) * 33 + n;
        u32x4 o; o.x = pk2(s[0 * 33], s[1 * 33]); o.y = pk2(s[2 * 33], s[3 * 33]); o.z = pk2(s[4 * 33], s[5 * 33]); o.w = pk2(s[6 * 33], s[7 * 33]);
        *(u32x4*)(J.dst + (size_t)rowmap(J.mode, n0 + n) * J.K + k0 + 8 * c) = o; }
    LDS_WAIT();
}
__device__ __forceinline__ void prologue(ArgsP a, LAS unsigned char* lds, int gw, int ngw, int lane, int wave) {
    LAS float* scr = (LAS float*)(lds + wave * 16384);
    int base = 0;
    for (int j = 0; j < NJOBS; ++j) {
        const Job J = get_job(a, j); const int nitems = (J.K / 64) * (J.N / 32);
        int first = gw - (base % ngw); if (first < 0) first += ngw;
        for (int it = first; it < nitems; it += ngw) transpose_item(J, scr, it, lane);
        base += nitems;
    }
    float* X = a->out; bf16* XB = (bf16*)(a->ws + WS_XB); float* ssq = (float*)(a->ws + WS_SSQ);
    for (int m = gw; m < MPAD; m += ngw) {
        u32x2* o8 = (u32x2*)(XB + (size_t)m * D) + lane;
        if (m < MR) {
            const float* src = (m < MP) ? a->in[I_XP] + (size_t)m * D : a->in[I_XS] + (size_t)(m - MP) * D;
            const f32x4* xr = (const f32x4*)src + lane; f32x4* xo = (f32x4*)(X + (size_t)m * D) + lane; float s = 0.f;
#pragma unroll
            for (int j = 0; j < 4; ++j) { const f32x4 v = xr[64 * j]; xo[64 * j] = v; s += (v[0] * v[0] + v[1] * v[1]) + (v[2] * v[2] + v[3] * v[3]);
                u32x2 w; w.x = pk2(v[0], v[1]); w.y = pk2(v[2], v[3]); o8[64 * j] = w; }
            s = wave_sum(s); if (lane == 0) ssq[m] = s;
        } else {
#pragma unroll
            for (int j = 0; j < 4; ++j) o8[64 * j] = (u32x2){0u, 0u};
            if (lane == 0) ssq[m] = 0.f;
        }
    }
    const int gt = gw * 64 + lane, ngt = ngw * 64;
    for (int i = gt; i < 12 * MPAD; i += ngt) ssq[MPAD + i] = 0.f;
    for (int i = gt; i < 2 * NSMP * 127 * 64; i += ngt) {
        const int which = i / (NSMP * 127 * 64), r = i % (NSMP * 127 * 64), b = r / (127 * 64), q = r % (127 * 64), jrow = q >> 6, c4 = q & 63;
        const f32x4 v = *((const f32x4*)(a->in[which ? I_CV : I_CK] + ((size_t)b * 128 + jrow + 1) * 256) + c4);
        *((f32x4*)(a->out + (which ? O_VS : O_KS) + ((size_t)b * 128 + jrow) * 256) + c4) = v;
    }
}

__device__ __forceinline__ void unpack8(const u32x4 w, float (&f)[8]) { f[0] = bflo(w.x); f[1] = bfhi(w.x); f[2] = bflo(w.y); f[3] = bfhi(w.y); f[4] = bflo(w.z); f[5] = bfhi(w.z); f[6] = bflo(w.w); f[7] = bfhi(w.w); }
__device__ __forceinline__ void conv_phase(ArgsP a, int layer, int gt, int ngt) {
    const bf16* CU = (const bf16*)(a->ws + WS_H); bf16* BZ = (bf16*)(a->ws + WS_H + SZ_ACT);
    const float* cw = a->in[I_CONVW] + (size_t)layer * 3 * D; const float* st = a->in[I_SCONV] + (size_t)layer * NSMP * 2 * D;
    float* convp = a->out + O_CONVP + (size_t)layer * 2 * 2 * D; float* convs = a->out + O_CONVS + (size_t)layer * NSMP * 2 * D;
    for (int idx = gt; idx < MR * 128; idx += ngt) {
        const int row = idx >> 7, c8 = (idx & 127) * 8;
        float b[8], c2[8], c1[8], c0[8];
        unpack8(*(const u32x4*)(BZ + (size_t)row * D + c8), b); unpack8(*(const u32x4*)(CU + (size_t)row * D + c8), c2);
        if (row < MP) {
            const int t = row & 8191;
            if (t >= 1) unpack8(*(const u32x4*)(CU + (size_t)(row - 1) * D + c8), c1); else { for (int e = 0; e < 8; ++e) c1[e] = 0.f; }
            if (t >= 2) unpack8(*(const u32x4*)(CU + (size_t)(row - 2) * D + c8), c0); else { for (int e = 0; e < 8; ++e) c0[e] = 0.f; }
            if (t >= 8190) { float* o = convp + ((size_t)(row >> 13) * 2 + (t - 8190)) * D + c8; *(f32x4*)o = (f32x4){c2[0], c2[1], c2[2], c2[3]}; *(f32x4*)(o + 4) = (f32x4){c2[4], c2[5], c2[6], c2[7]}; }
        } else {
            const int bs = row - MP; const float* s0 = st + ((size_t)bs * 2) * D + c8;
            const f32x4 a0 = *(const f32x4*)s0, a1 = *(const f32x4*)(s0 + 4), b0 = *(const f32x4*)(s0 + D), b1 = *(const f32x4*)(s0 + D + 4);
#pragma unroll
            for (int e = 0; e < 4; ++e) { c0[e] = a0[e]; c0[4 + e] = a1[e]; c1[e] = b0[e]; c1[4 + e] = b1[e]; }
            float* o = convs + ((size_t)bs * 2) * D + c8;
            *(f32x4*)o = b0; *(f32x4*)(o + 4) = b1; *(f32x4*)(o + D) = (f32x4){c2[0], c2[1], c2[2], c2[3]}; *(f32x4*)(o + D + 4) = (f32x4){c2[4], c2[5], c2[6], c2[7]};
        }
        const f32x4 w0a = *(const f32x4*)(cw + c8), w0b = *(const f32x4*)(cw + c8 + 4), w1a = *(const f32x4*)(cw + D + c8), w1b = *(const f32x4*)(cw + D + c8 + 4), w2a = *(const f32x4*)(cw + 2 * D + c8), w2b = *(const f32x4*)(cw + 2 * D + c8 + 4);
        float z[8];
#pragma unroll
        for (int e = 0; e < 4; ++e) { z[e] = b[e] * (w0a[e] * c0[e] + w1a[e] * c1[e] + w2a[e] * c2[e]); z[4 + e] = b[4 + e] * (w0b[e] * c0[4 + e] + w1b[e] * c1[4 + e] + w2b[e] * c2[4 + e]); }
        u32x4 w; w.x = pk2(z[0], z[1]); w.y = pk2(z[2], z[3]); w.z = pk2(z[4], z[5]); w.w = pk2(z[6], z[7]);
        *(u32x4*)(BZ + (size_t)row * D + c8) = w;
    }
}

constexpr int KROW = 144, VROW = 560, KL_BYTES = 272 * KROW, VT_OFF = 40960, VT_BYTES = 64 * VROW, SMP_OFF = 81920;
static_assert(KL_BYTES <= VT_OFF && VT_OFF + VT_BYTES <= SMP_OFF, "attention LDS map");
__device__ __forceinline__ void attn_phase(ArgsP a, int j, LAS unsigned char* lds, int tid, int lane, int wave, int bid, int G) {
    const bf16* Qb = (const bf16*)(a->ws + WS_H); bf16* Ob = (bf16*)(a->ws + WS_H + SZ_ACT);
    const bf16* Kb = (const bf16*)(a->ws + WS_KB); const bf16* Vt = (const bf16*)(a->ws + WS_VT);
    const float* sinks = a->in[I_SINKS] + j * 16;
    const int fr = lane & 15, fq = lane >> 4;
    for (int unit = bid; unit < 512; unit += G) {
        const int b = unit >> 8, kvh = (unit >> 6) & 3, qblk = unit & 63, t0 = qblk * 128;
        __syncthreads();
        for (int c = tid; c < 272 * 8; c += NTHREADS) { const int row = c >> 3, ch = c & 7, t = t0 - 128 + row;
            u32x4 v = (u32x4){0u, 0u, 0u, 0u}; if (row < 256 && t >= 0) v = *(const u32x4*)(Kb + ((size_t)b * SEQ + t) * 256 + kvh * 64 + ch * 8);
            *(LAS u32x4*)(lds + row * KROW + ch * 16) = v; }
        for (int c = tid; c < 64 * 34; c += NTHREADS) { const int d = c / 34, ch = c % 34, t = t0 - 128 + ch * 8;
            u32x4 v = (u32x4){0u, 0u, 0u, 0u}; if (ch < 32 && t >= 0) v = *(const u32x4*)(Vt + ((size_t)(b * 4 + kvh) * 64 + d) * SEQ + t);
            *(LAS u32x4*)(lds + VT_OFF + d * VROW + ch * 16) = v; }
        __syncthreads();
        const int head = kvh * 4 + (wave >> 1); const float sink = sinks[head];
        for (int qt = 0; qt < 4; ++qt) {
            const int q0 = (wave & 1) * 64 + qt * 16, cb = q0 >> 4;
            const size_t grow = (size_t)b * SEQ + t0 + q0 + fr;
            const bf16x8 qf0 = *(const bf16x8*)(Qb + grow * D + head * 64 + fq * 8), qf1 = *(const bf16x8*)(Qb + grow * D + head * 64 + 32 + fq * 8);
            f32x4 s[10];
#pragma unroll
            for (int c = 0; c < 10; ++c) {
                const LAS unsigned char* kp = lds + (16 * (cb + c) + fr) * KROW + fq * 16;
                f32x4 acc = (f32x4){0.f, 0.f, 0.f, 0.f};
                acc = __builtin_amdgcn_mfma_f32_16x16x32_bf16(*(const LAS bf16x8*)kp, qf0, acc, 0, 0, 0);
                acc = __builtin_amdgcn_mfma_f32_16x16x32_bf16(*(const LAS bf16x8*)(kp + 64), qf1, acc, 0, 0, 0);
                s[c] = acc;
            }
            const int qi = q0 + fr; float mx = -INFINITY;
#pragma unroll
            for (int c = 0; c < 10; ++c)
#pragma unroll
                for (int i = 0; i < 4; ++i) { const int kj = 16 * (cb + c) + 4 * fq + i; const bool ok = (kj >= qi + 1) && (kj <= qi + 128) && (qblk > 0 || kj >= 128);
                    s[c][i] = ok ? s[c][i] : -INFINITY; mx = fmaxf(mx, s[c][i]); }
            mx = fmaxf(mx, __shfl_xor(mx, 16)); mx = fmaxf(mx, __shfl_xor(mx, 32)); mx = fmaxf(mx, sink);
            float sum = 0.f;
#pragma unroll
            for (int c = 0; c < 10; ++c)
#pragma unroll
                for (int i = 0; i < 4; ++i) { const float p = __expf(s[c][i] - mx); s[c][i] = p; sum += p; }
            sum += __shfl_xor(sum, 16); sum += __shfl_xor(sum, 32);
            const float inv = 1.0f / (sum + __expf(sink - mx));
            bf16x8 pb[5];
#pragma unroll
            for (int pp = 0; pp < 5; ++pp) { u32x4 w; w.x = pk2(s[2 * pp][0], s[2 * pp][1]); w.y = pk2(s[2 * pp][2], s[2 * pp][3]); w.z = pk2(s[2 * pp + 1][0], s[2 * pp + 1][1]); w.w = pk2(s[2 * pp + 1][2], s[2 * pp + 1][3]);
                pb[pp] = __builtin_bit_cast(bf16x8, w); }
#pragma unroll
            for (int dt = 0; dt < 4; ++dt) {
                f32x4 o = (f32x4){0.f, 0.f, 0.f, 0.f};
#pragma unroll
                for (int pp = 0; pp < 5; ++pp) {
                    const LAS unsigned char* vp = lds + VT_OFF + (16 * dt + fr) * VROW + (16 * (cb + 2 * pp) + 4 * fq) * 2;
                    const u32x2 lo = *(const LAS u32x2*)vp, hi = *(const LAS u32x2*)(vp + 32);
                    const u32x4 av = (u32x4){lo.x, lo.y, hi.x, hi.y};
                    o = __builtin_amdgcn_mfma_f32_16x16x32_bf16(__builtin_bit_cast(bf16x8, av), pb[pp], o, 0, 0, 0);
                }
                o = o * inv; u32x2 w; w.x = pk2(o[0], o[1]); w.y = pk2(o[2], o[3]);
                *(u32x2*)(Ob + grow * D + head * 64 + 16 * dt + 4 * fq) = w;
            }
        }
    }
    __syncthreads();
    LAS float* wq = (LAS float*)(lds + SMP_OFF + wave * 1024); LAS float* wsc = wq + 64;
    for (int task = bid * NWAVES + wave; task < NSMP * 16; task += G * NWAVES) {
        const int b = task >> 4, h = task & 15, kvh = h >> 2; const float sink = sinks[h];
        const size_t qoff = (size_t)(MP + b) * D + h * 64;
        wq[lane] = bf2f(Qb[qoff + lane]);
        LDS_WAIT();
        const int sub = lane >> 4, dq = lane & 15;
        const f32x4 q4 = *(const LAS f32x4*)(wq + 4 * dq);
        const float* ks = a->out + O_KS + (size_t)b * 128 * 256 + kvh * 64; const float* vs = a->out + O_VS + (size_t)b * 128 * 256 + kvh * 64;
        for (int it = 0; it < 32; ++it) { const int key = it * 4 + sub; const f32x4 k4 = *(const f32x4*)(ks + (size_t)key * 256 + 4 * dq);
            float p = (q4[0] * k4[0] + q4[1] * k4[1]) + (q4[2] * k4[2] + q4[3] * k4[3]);
            p += __shfl_xor(p, 1); p += __shfl_xor(p, 2); p += __shfl_xor(p, 4); p += __shfl_xor(p, 8);
            if (dq == 0) wsc[key] = p; }
        LDS_WAIT();
        const float s0 = wsc[lane], s1 = wsc[lane + 64];
        const float mx = fmaxf(wave_max(fmaxf(s0, s1)), sink);
        const float p0 = __expf(s0 - mx), p1 = __expf(s1 - mx);
        const float inv = 1.0f / (wave_sum(p0 + p1) + __expf(sink - mx));
        LDS_WAIT();
        wsc[lane] = p0; wsc[lane + 64] = p1;
        LDS_WAIT();
        float o = 0.f;
#pragma unroll 8
        for (int key = 0; key < 128; ++key) o += wsc[key] * vs[(size_t)key * 256 + lane];
        Ob[qoff + lane] = (bf16)f2bf(o * inv);
        LDS_WAIT();
    }
}
#ifndef KMASK
#define KMASK 511
#endif
constexpr int NSTEPS = 30;
template <class Epi>
__device__ __forceinline__ void run_gemm(int tid, int bid, int G, LAS unsigned char* lds, const bf16* A, const bf16* Bt, int M, int N, int K, const Epi& E) {
    pg8::Gemm g{A, Bt, M, N, K}; pg8::StaticOrder S; S.init(M, N, G, bid);
    pg8::gemm_phase<Epi, pg8::StaticOrder, true, true>(tid, lds, g, S, E);
}
__global__ void __launch_bounds__(NTHREADS, 2) yoco_fwd(Args a) {
    extern __shared__ __attribute__((aligned(16))) unsigned char lds_raw[];
    LAS unsigned char* lds = (LAS unsigned char*)lds_raw;
    cg::grid_group grid = cg::this_grid();
    const int ph_hi = a.ph_hi;
    for (int s = a.ph_lo; s < ph_hi; ++s) {
        ArgsP ap = (ArgsP)__builtin_amdgcn_kernarg_segment_ptr(); asm volatile("" : "+s"(ap));
        int tid = threadIdx.x; asm volatile("" : "+v"(tid));
        int bid = blockIdx.x, G = gridDim.x; asm volatile("" : "+s"(bid), "+s"(G));
        const int lane = tid & 63, wave = __builtin_amdgcn_readfirstlane(tid >> 6);
        const int gw = bid * NWAVES + wave, ngw = G * NWAVES, gt = bid * NTHREADS + tid, ngt = G * NTHREADS;
        unsigned char* ws = ap->ws;
        float* ssq = (float*)(ws + WS_SSQ); float* X = ap->out; bf16* XB = (bf16*)(ws + WS_XB); bf16* H = (bf16*)(ws + WS_H);
        bf16* CUQ = (bf16*)(ws + WS_H); bf16* BZO = (bf16*)(ws + WS_H + SZ_ACT);
        int kind, l = 0, f = 0;
        if (s == 0) kind = 0;
        else if (s == 15) kind = 9;
        else { const int r = (s < 15) ? s - 1 : s - 2; l = r / 7; const int jj = r % 7;
            if (jj == 0) { kind = 1; f = 0; } else if (jj == 1) { kind = 2; f = 0; } else if (jj == 5) { kind = 1; f = 1; } else if (jj == 6) { kind = 2; f = 1; }
            else kind = (l < 2 ? 3 : 6) + (jj - 2); }
        if (kind == 0 && (KMASK & 1)) prologue(ap, lds, gw, ngw, lane, wave);
        else if (kind == 1 && (KMASK & 2)) {
            pg8::EpiSwiGLU E{H, ssq + (size_t)(3 * l + 2 * f) * MPAD};
            run_gemm(tid, bid, G, lds, XB, (const bf16*)(ws + WS_WGU + (size_t)(2 * l + f) * SZ_WGU), MPAD, 2 * FF, D, E);
        } else if (kind == 2 && (KMASK & 4)) {
            pg8::EpiResid E{X, XB, ssq + (size_t)(3 * l + 2 * f + 1) * MPAD, 0.5f};
            run_gemm(tid, bid, G, lds, H, (const bf16*)(ws + WS_WD + (size_t)(2 * l + f) * SZ_WD), MPAD, D, FF, E);
        } else if (kind == 3 && (KMASK & 8)) {
            pg8::EpiInProj E{CUQ, BZO, ssq + (size_t)(3 * l + 1) * MPAD};
            run_gemm(tid, bid, G, lds, XB, (const bf16*)(ws + WS_WIN + (size_t)l * 3 * D * D * 2), MPAD, 3 * D, D, E);
        } else if (kind == 4 && (KMASK & 16)) conv_phase(ap, l, gt, ngt);
        else if ((kind == 5 || kind == 8) && (KMASK & 32)) {
            pg8::EpiResid E{X, XB, ssq + (size_t)(3 * l + 2) * MPAD, 1.0f};
            const bf16* Bt = (kind == 5) ? (const bf16*)(ws + WS_WOUT + (size_t)l * D * D * 2) : (const bf16*)(ws + WS_WO + (size_t)(l - 2) * D * D * 2);
            run_gemm(tid, bid, G, lds, BZO, Bt, MPAD, D, D, E);
        } else if (kind == 6 && (KMASK & 64)) {
            pg8::EpiQ E{CUQ, ssq + (size_t)(3 * l + 1) * MPAD, ap->in[I_GQN] + (l - 2) * 64};
            run_gemm(tid, bid, G, lds, XB, (const bf16*)(ws + WS_WQ + (size_t)(l - 2) * D * D * 2), MPAD, D, D, E);
        } else if (kind == 7 && (KMASK & 128)) attn_phase(ap, l - 2, lds, tid, lane, wave, bid, G);
        else if (kind == 9 && (KMASK & 256)) {
            pg8::EpiKV E{(bf16*)(ws + WS_KB), (bf16*)(ws + WS_VT), ssq + (size_t)6 * MPAD, ap->in[I_GKN], ap->out + O_KP, ap->out + O_VP, ap->out + O_KS, ap->out + O_VS};
            run_gemm(tid, bid, G, lds, XB, (const bf16*)(ws + WS_WKV), MPAD, 512, D, E);
        }
        if (s + 1 < ph_hi) grid.sync();
    }
}

extern "C" void kernel_launch(void* const* d_in, const int* in_sizes, int n_in, void* d_out, int out_size, void* d_ws, size_t ws_size, hipStream_t stream) {
    static int grid = 0;
    if (grid == 0) {
        if (n_in != N_IN || (size_t)out_size != O_END || ws_size < WS_END) { fprintf(stderr, "kernel_launch: unexpected shapes: n_in %d out %d ws %zu (need %zu)\n", n_in, out_size, ws_size, (size_t)WS_END); grid = -1; return; }
        int dev = 0, cus = 0, per_cu = 0;
        hipGetDevice(&dev); hipDeviceGetAttribute(&cus, hipDeviceAttributeMultiprocessorCount, dev);
        if (hipFuncSetAttribute((const void*)yoco_fwd, hipFuncAttributeMaxDynamicSharedMemorySize, LDS_BYTES) != hipSuccess) { fprintf(stderr, "kernel_launch: hipFuncSetAttribute failed\n"); grid = -1; return; }
        if (hipOccupancyMaxActiveBlocksPerMultiprocessor(&per_cu, (const void*)yoco_fwd, NTHREADS, LDS_BYTES) != hipSuccess || per_cu < 1) { fprintf(stderr, "kernel_launch: occupancy query says %d\n", per_cu); per_cu = 1; }
        (void)hipGetLastError();
        grid = cus * 1;
    }
    if (grid < 0) return;
    Args a{};
    for (int i = 0; i < N_IN; ++i) a.in[i] = (const float*)d_in[i];
    a.out = (float*)d_out; a.ws = (unsigned char*)d_ws;
#if N_LAUNCH_PER_PHASE
    for (int s = 0; s < NSTEPS; ++s) { a.ph_lo = s; a.ph_hi = s + 1; hipLaunchKernelGGL(yoco_fwd, dim3(grid), dim3(NTHREADS), LDS_BYTES, stream, a); }
#else
    a.ph_lo = 0; a.ph_hi = NSTEPS;
    void* args[] = {&a};
    hipError_t e = hipLaunchCooperativeKernel((const void*)yoco_fwd, dim3(grid), dim3(NTHREADS), args, LDS_BYTES, stream);
    if (e != hipSuccess) fprintf(stderr, "kernel_launch: cooperative launch failed: %s (grid %d)\n", hipGetErrorString(e), grid);
#endif
}
```

```cpp
#include <hip/hip_runtime.h>
#include <hip/hip_cooperative_groups.h>
#include <cstdio>
#include <cstdint>
namespace cg = cooperative_groups;
#define N_LAUNCH_PER_PHASE 0
namespace pg8 {
#define PG8_LAS __attribute__((address_space(3)))
typedef unsigned short bf16_t;
typedef short bf16x8 __attribute__((ext_vector_type(8)));
typedef float f32x4 __attribute__((ext_vector_type(4)));
typedef unsigned u32x4 __attribute__((ext_vector_type(4)));
constexpr int BM = 256, BK = 64, HALF = 128, HTB = HALF * BK * 2  , STAGE_BYTES = 8 * HTB, NXCD = 8, WGM = 8;

__host__ __device__ __forceinline__ int lds_byte(int r, int c) { const int st = (r >> 4) * 2 + (c >> 5), rr = r & 15, cc = c & 31, ob = rr * 64 + cc * 2; return st * 1024 + (ob ^ (((ob >> 9) & 1) << 5)); }
__host__ __device__ __forceinline__ void stage_rc(int b, int& R, int& C) { const int st = b / 1024, sb = b % 1024, swz = sb ^ (((sb >> 9) & 1) << 5); R = (st >> 1) * 16 + swz / 64; C = (st & 1) * 32 + (swz % 64) / 2; }
__host__ __device__ __forceinline__ int perm32(int rho) { const int n = rho >> 4, i = rho & 15; return 8 * (i >> 2) + 4 * n + (i & 3); }

struct Unit { int pm, pn; };
struct Gemm { const bf16_t* A; const bf16_t* Bt; int M, N, K; };

struct StaticOrder {
    int nM, nN, nwg, G, c;
    __host__ __device__ void init(int M, int N, int G_, int c_) { nM = M / BM; nN = N / BM; nwg = nM * nN; G = G_; c = c_; }
    __host__ __device__ bool next(int i, Unit& u) const {
        const long L = (long)i * G + c; if (L >= nwg) return false;
        int wgid = (int)L; { const int q = nwg / NXCD, r = nwg % NXCD, xcd = wgid % NXCD, off = wgid / NXCD; wgid = (xcd < r ? xcd * (q + 1) : r * (q + 1) + (xcd - r) * q) + off; }
        const int nig = WGM * nN, gid = wgid / nig, fm = gid * WGM, gsz = (nM - fm) < WGM ? (nM - fm) : WGM;
        u.pm = fm + ((wgid % nig) % gsz); u.pn = (wgid % nig) / gsz; return true;
    }
    __device__ __forceinline__ void a_ready(const Unit&) const {}
    __device__ __forceinline__ void done(const Unit&) const {}
};

__device__ __forceinline__ unsigned cvt_pk_bf16(float lo, float hi) { unsigned r; asm volatile("v_cvt_pk_bf16_f32 %0, %1, %2" : "=v"(r) : "v"(lo), "v"(hi)); return r; }
typedef unsigned u32x2 __attribute__((ext_vector_type(2)));
constexpr int ROWS_REAL = 16512, ROWS_PROMPT = 16384, DM = 1024, DFF = 2816;
__device__ __forceinline__ float row_rstd(const float* ssq, int row) { return __builtin_amdgcn_rsqf(ssq[row] * (1.0f / 1024.0f) + 1e-6f); }
__device__ __forceinline__ float silu_mul(float g, float u) { return g * __builtin_amdgcn_rcpf(1.0f + __expf(-g)) * u; }

struct EpiSwiGLU {
    static constexpr bool PERM = true, AFTER_DRAIN = false;
    bf16_t* H; const float* ssq;
    __device__ __forceinline__ void operator()(const f32x4 (&acc)[2][2][4][2], const Unit& u, int wr, int wc, int fr, int fq) const {
        const int row0 = u.pm * BM + wr * 64 + fr, col0 = u.pn * 128 + wc * 32 + 8 * fq;
#pragma unroll
        for (int ai = 0; ai < 2; ++ai)
#pragma unroll
            for (int m = 0; m < 4; ++m) {
                const int row = row0 + ai * HALF + m * 16; const float r = row_rstd(ssq, row);
                const f32x4 g0 = acc[ai][0][m][0] * r, g1 = acc[ai][0][m][1] * r, u0 = acc[ai][1][m][0] * r, u1 = acc[ai][1][m][1] * r;
                u32x4 w;
                w.x = cvt_pk_bf16(silu_mul(g0[0], u0[0]), silu_mul(g0[1], u0[1])); w.y = cvt_pk_bf16(silu_mul(g0[2], u0[2]), silu_mul(g0[3], u0[3]));
                w.z = cvt_pk_bf16(silu_mul(g1[0], u1[0]), silu_mul(g1[1], u1[1])); w.w = cvt_pk_bf16(silu_mul(g1[2], u1[2]), silu_mul(g1[3], u1[3]));
                *(u32x4*)(H + (size_t)row * DFF + col0) = w;
            }
    }
};

struct EpiResid {
    static constexpr bool PERM = false, AFTER_DRAIN = false;
    float* X; bf16_t* XB; float* ssq_next; float scale;
    __device__ __forceinline__ void operator()(const f32x4 (&acc)[2][2][4][2], const Unit& u, int wr, int wc, int fr, int fq) const {
        const int row0 = u.pm * BM + wr * 64 + fr, col0 = u.pn * BM + wc * 32 + 4 * fq;
#pragma unroll
        for (int ai = 0; ai < 2; ++ai) {
            if (u.pm * BM + ai * HALF >= ROWS_REAL) continue;
#pragma unroll
            for (int m = 0; m < 4; ++m) {
                const int row = row0 + ai * HALF + m * 16; float ss = 0.f;
#pragma unroll
                for (int bj = 0; bj < 2; ++bj)
#pragma unroll
                    for (int n = 0; n < 2; ++n) {
                        const size_t off = (size_t)row * DM + col0 + bj * HALF + n * 16;
                        f32x4 x = *(const f32x4*)(X + off); x = x + acc[ai][bj][m][n] * scale; *(f32x4*)(X + off) = x;
                        u32x2 w; w.x = cvt_pk_bf16(x[0], x[1]); w.y = cvt_pk_bf16(x[2], x[3]); *(u32x2*)(XB + off) = w;
                        ss += (x[0] * x[0] + x[1] * x[1]) + (x[2] * x[2] + x[3] * x[3]);
                    }
                ss += __shfl_xor(ss, 16); ss += __shfl_xor(ss, 32);
                if (fq == 0) __hip_atomic_fetch_add(ssq_next + row, ss, __ATOMIC_RELAXED, __HIP_MEMORY_SCOPE_AGENT);
            }
        }
    }
};

struct EpiInProj {
    static constexpr bool PERM = true, AFTER_DRAIN = false;
    bf16_t* CU; bf16_t* BZ; const float* ssq;
    __device__ __forceinline__ void operator()(const f32x4 (&acc)[2][2][4][2], const Unit& u, int wr, int wc, int fr, int fq) const {
        const int row0 = u.pm * BM + wr * 64 + fr;
#pragma unroll
        for (int ai = 0; ai < 2; ++ai)
#pragma unroll
            for (int m = 0; m < 4; ++m) {
                const int row = row0 + ai * HALF + m * 16; const float r = row_rstd(ssq, row);
                if (u.pn < 8) {
                    const float r2 = r * r; const f32x4 p0 = acc[ai][0][m][0] * acc[ai][1][m][0] * r2, p1 = acc[ai][0][m][1] * acc[ai][1][m][1] * r2;
                    u32x4 w; w.x = cvt_pk_bf16(p0[0], p0[1]); w.y = cvt_pk_bf16(p0[2], p0[3]); w.z = cvt_pk_bf16(p1[0], p1[1]); w.w = cvt_pk_bf16(p1[2], p1[3]);
                    *(u32x4*)(CU + (size_t)row * DM + u.pn * 128 + wc * 32 + 8 * fq) = w;
                } else {
#pragma unroll
                    for (int bj = 0; bj < 2; ++bj) {
                        const f32x4 p0 = acc[ai][bj][m][0] * r, p1 = acc[ai][bj][m][1] * r;
                        u32x4 w; w.x = cvt_pk_bf16(p0[0], p0[1]); w.y = cvt_pk_bf16(p0[2], p0[3]); w.z = cvt_pk_bf16(p1[0], p1[1]); w.w = cvt_pk_bf16(p1[2], p1[3]);
                        *(u32x4*)(BZ + (size_t)row * DM + (u.pn - 8) * BM + bj * HALF + wc * 32 + 8 * fq) = w;
                    }
                }
            }
    }
};

__device__ __forceinline__ void head_norm_rope(f32x4 (&v)[2][2], const f32x4 (&g)[2][2], int pos, int fq) {
    float ss = 0.f;
#pragma unroll
    for (int bj = 0; bj < 2; ++bj)
#pragma unroll
        for (int n = 0; n < 2; ++n) ss += (v[bj][n][0] * v[bj][n][0] + v[bj][n][1] * v[bj][n][1]) + (v[bj][n][2] * v[bj][n][2] + v[bj][n][3] * v[bj][n][3]);
    ss += __shfl_xor(ss, 16); ss += __shfl_xor(ss, 32);
    const float hr = __builtin_amdgcn_rsqf(ss * (1.0f / 64.0f) + 1e-6f);
#pragma unroll
    for (int bj = 0; bj < 2; ++bj)
#pragma unroll
        for (int n = 0; n < 2; ++n) v[bj][n] = v[bj][n] * hr * g[bj][n];
    const f32x4 x = v[0][0]; f32x4 o;
    const bool lo = (fq & 1) == 0;
    const float f0 = lo ? 1.0f : 0.001414213562373095f, f1 = lo ? 0.19392274474868576f : 0.0002742481756762073f;
    const float f2 = lo ? 0.03760603093086393f : 5.318295896944988e-05f, f3 = lo ? 0.007292664737217109f : 1.031338537721246e-05f;
    const float fr4[4] = {f0, f1, f2, f3};
#pragma unroll
    for (int e = 0; e < 4; ++e) {
        const float partner = __shfl_xor(x[e], 32);
        const float ang = (float)pos * fr4[e];
        double rev = (double)ang * 0.15915494309189535; rev -= __builtin_floor(rev);
        const float rv = (float)rev; const float s = __builtin_amdgcn_sinf(rv), c = __builtin_amdgcn_cosf(rv);
        o[e] = (fq < 2) ? (x[e] * c - partner * s) : (x[e] * c + partner * s);
    }
    v[0][0] = o;
}
__device__ __forceinline__ int row_pos(int row) { return row < ROWS_PROMPT ? (row & 8191) : 8192; }

struct EpiQ {
    static constexpr bool PERM = false, AFTER_DRAIN = false;
    bf16_t* Qb; const float* ssq; const float* gq;
    __device__ __forceinline__ void operator()(const f32x4 (&acc)[2][2][4][2], const Unit& u, int wr, int wc, int fr, int fq) const {
        const int row0 = u.pm * BM + wr * 64 + fr; const int colh = u.pn * BM + 64 * wc + 4 * fq;
        f32x4 g[2][2];
#pragma unroll
        for (int bj = 0; bj < 2; ++bj)
#pragma unroll
            for (int n = 0; n < 2; ++n) g[bj][n] = *(const f32x4*)(gq + 32 * bj + 16 * n + 4 * fq);
#pragma unroll
        for (int ai = 0; ai < 2; ++ai)
#pragma unroll
            for (int m = 0; m < 4; ++m) {
                const int row = row0 + ai * HALF + m * 16; const float r = row_rstd(ssq, row);
                f32x4 v[2][2];
#pragma unroll
                for (int bj = 0; bj < 2; ++bj)
#pragma unroll
                    for (int n = 0; n < 2; ++n) v[bj][n] = acc[ai][bj][m][n] * r;
                head_norm_rope(v, g, row_pos(row), fq);
#pragma unroll
                for (int bj = 0; bj < 2; ++bj)
#pragma unroll
                    for (int n = 0; n < 2; ++n) { const f32x4 x = v[bj][n] * 0.125f; u32x2 w; w.x = cvt_pk_bf16(x[0], x[1]); w.y = cvt_pk_bf16(x[2], x[3]);
                        *(u32x2*)(Qb + (size_t)row * DM + colh + 32 * bj + 16 * n) = w; }
            }
    }
};

struct EpiKV {
    static constexpr bool PERM = false, AFTER_DRAIN = false;
    bf16_t* Kb; bf16_t* Vt; const float* ssq; const float* gk; float* ckp; float* cvp; float* cks; float* cvs;
    __device__ __forceinline__ void operator()(const f32x4 (&acc)[2][2][4][2], const Unit& u, int wr, int wc, int fr, int fq) const {
        const int row0 = u.pm * BM + wr * 64 + fr; const int colh = 64 * wc + 4 * fq; const bool isk = (u.pn == 0);
        f32x4 g[2][2];
#pragma unroll
        for (int bj = 0; bj < 2; ++bj)
#pragma unroll
            for (int n = 0; n < 2; ++n) g[bj][n] = *(const f32x4*)(gk + 32 * bj + 16 * n + 4 * fq);
#pragma unroll
        for (int ai = 0; ai < 2; ++ai) {
            if (u.pm * BM + ai * HALF >= ROWS_REAL) continue;
#pragma unroll
            for (int m = 0; m < 4; ++m) {
                const int row = row0 + ai * HALF + m * 16; const float r = row_rstd(ssq, row);
                f32x4 v[2][2];
#pragma unroll
                for (int bj = 0; bj < 2; ++bj)
#pragma unroll
                    for (int n = 0; n < 2; ++n) v[bj][n] = acc[ai][bj][m][n] * r;
                if (isk) head_norm_rope(v, g, row_pos(row), fq);
                float* cache = nullptr;
                if (row >= ROWS_PROMPT) cache = (isk ? cks : cvs) + ((size_t)(row - ROWS_PROMPT) * 128 + 127) * 256;
                else { const int t = row & 8191, b = row >> 13; if (t >= 8192 - 128) cache = (isk ? ckp : cvp) + ((size_t)b * 128 + (t - (8192 - 128))) * 256; }
#pragma unroll
                for (int bj = 0; bj < 2; ++bj)
#pragma unroll
                    for (int n = 0; n < 2; ++n) {
                        const f32x4 x = v[bj][n]; const int c = colh + 32 * bj + 16 * n;
                        if (cache) *(f32x4*)(cache + c) = x;
                        if (row < ROWS_PROMPT) {
                            if (isk) { u32x2 w; w.x = cvt_pk_bf16(x[0], x[1]); w.y = cvt_pk_bf16(x[2], x[3]); *(u32x2*)(Kb + (size_t)row * 256 + c) = w; }
                            else { const int t = row & 8191, b = row >> 13; const int d = 4 * fq + 32 * bj + 16 * n;
                                bf16_t* vp = Vt + ((size_t)(b * 4 + wc) * 64 + d) * 8192 + t;
                                const unsigned w0 = cvt_pk_bf16(x[0], x[1]), w1 = cvt_pk_bf16(x[2], x[3]);
                                vp[0] = (bf16_t)(w0 & 0xffffu); vp[8192] = (bf16_t)(w0 >> 16); vp[2 * 8192] = (bf16_t)(w1 & 0xffffu); vp[3 * 8192] = (bf16_t)(w1 >> 16); }
                        }
                    }
            }
        }
    }
};
template <class Epi, class Sched, bool ALIGN_EPI = false, bool SP2 = false>
__device__ __forceinline__ void gemm_phase(const int tid, PG8_LAS unsigned char* lds, const Gemm g, const Sched& S, const Epi& E) {
    const int wid = __builtin_amdgcn_readfirstlane(tid >> 6), lane = tid & 63, wr = wid >> 2, wc = wid & 3, fr = lane & 15, fq = lane >> 4;
    const int K = g.K, nt = K / BK;
    unsigned voffA[2], voffB[2];
#pragma unroll
    for (int i = 0; i < 2; ++i) { int R, C; stage_rc(tid * 16 + i * 8192, R, C); const int Rb = Epi::PERM ? ((R & ~31) + perm32(R & 31)) : R;
        voffA[i] = (unsigned)(R * K + C) * 2u; voffB[i] = (unsigned)(Rb * K + C) * 2u; }
    const size_t kstep = (size_t)(BK * 2);
    const size_t hstep = (size_t)HALF * K * 2;
    const size_t tstep = 2 * hstep;
    const unsigned ldsw = (unsigned)wid * 1024u;
    const int aoff = lds_byte(wr * 64 + fr, fq * 8), boff = lds_byte(wc * 32 + fr, fq * 8);
#define PG8_SA(b, h) (((b) * 2 + (h)) * HTB)
#define PG8_SB(b, h) ((4 + (b) * 2 + (h)) * HTB)
#define PG8_STAGE(bufoff, gbase, voff) do { _Pragma("unroll") for (int _i = 0; _i < 2; ++_i) \
        __builtin_amdgcn_global_load_lds((const unsigned*)((const char*)(gbase) + (voff)[_i]), (PG8_LAS unsigned*)(lds + (bufoff) + ldsw + _i * 8192), 16, 0, 0); } while (0)
#define PG8_LDA(dst, b, h) do { _Pragma("unroll") for (int m = 0; m < 4; ++m) _Pragma("unroll") for (int k = 0; k < 2; ++k) dst[m][k] = *(const PG8_LAS bf16x8*)(lds + PG8_SA(b, h) + aoff + m * 2048 + k * 1024); } while (0)
#define PG8_LDB(dst, b, h) do { _Pragma("unroll") for (int n = 0; n < 2; ++n) _Pragma("unroll") for (int k = 0; k < 2; ++k) dst[n][k] = *(const PG8_LAS bf16x8*)(lds + PG8_SB(b, h) + boff + n * 2048 + k * 1024); } while (0)
#define PG8_MMA(ai, bj, At, Bt) do { __builtin_amdgcn_s_setprio(1); _Pragma("unroll") for (int m = 0; m < 4; ++m) _Pragma("unroll") for (int n = 0; n < 2; ++n) _Pragma("unroll") for (int k = 0; k < 2; ++k) \
        acc[ai][bj][m][n] = __builtin_amdgcn_mfma_f32_16x16x32_bf16(Bt[n][k], At[m][k], acc[ai][bj][m][n], 0, 0, 0); __builtin_amdgcn_s_setprio(0); } while (0)
#define PG8_WAIT_V(n) asm volatile("s_waitcnt vmcnt(" #n ")" ::: "memory")
#define PG8_WAIT_L(n) asm volatile("s_waitcnt lgkmcnt(" #n ")" ::: "memory")
#define PG8_BAR __builtin_amdgcn_s_barrier()
#define PG8_SCHED __builtin_amdgcn_sched_barrier(0)
    Unit cur, nxt; int ui = 0;
    if (!S.next(0, cur)) return;
    f32x4 acc[2][2][4][2];
#pragma unroll
    for (int a = 0; a < 2; ++a)
#pragma unroll
        for (int b = 0; b < 2; ++b)
#pragma unroll
            for (int m = 0; m < 4; ++m)
#pragma unroll
                for (int n = 0; n < 2; ++n) acc[a][b][m][n] = (f32x4){0.f, 0.f, 0.f, 0.f};
    bf16x8 At[4][2], B0[2][2], B1[2][2];
    const char* cA = (const char*)g.A + (size_t)cur.pm * tstep; const char* cB = (const char*)g.Bt + (size_t)cur.pn * tstep;
    S.a_ready(cur);
    if constexpr (SP2) {
        PG8_STAGE(PG8_SB(0, 0), cB, voffB); PG8_STAGE(PG8_SB(0, 1), cB + hstep, voffB); PG8_STAGE(PG8_SA(0, 0), cA, voffA); PG8_STAGE(PG8_SA(0, 1), cA + hstep, voffA);
        if (wr == 1) PG8_BAR;
        PG8_WAIT_V(2); PG8_BAR;
        PG8_STAGE(PG8_SB(1, 0), cB + kstep, voffB); PG8_STAGE(PG8_SA(1, 0), cA + kstep, voffA); PG8_STAGE(PG8_SB(1, 1), cB + hstep + kstep, voffB);
        PG8_WAIT_V(6); PG8_BAR;
    } else {
        PG8_STAGE(PG8_SB(0, 0), cB, voffB); PG8_STAGE(PG8_SA(0, 0), cA, voffA); PG8_STAGE(PG8_SB(0, 1), cB + hstep, voffB); PG8_STAGE(PG8_SA(0, 1), cA + hstep, voffA);
        if (wr == 1) PG8_BAR;
        PG8_WAIT_V(4); PG8_BAR;
        PG8_STAGE(PG8_SB(1, 0), cB + kstep, voffB); PG8_STAGE(PG8_SA(1, 0), cA + kstep, voffA); PG8_STAGE(PG8_SB(1, 1), cB + hstep + kstep, voffB);
        PG8_WAIT_V(6); PG8_BAR;
    }
    for (;;) {
        const bool has_next = S.next(ui + 1, nxt);
        const char* nA = has_next ? (const char*)g.A + (size_t)nxt.pm * tstep : cA; const char* nB = has_next ? (const char*)g.Bt + (size_t)nxt.pn * tstep : cB;
        for (int t = 0; t < nt; t += 2) {
            const bool last = (t == nt - 2);
            const char* a1 = cA + (size_t)(t + 1) * kstep;
            const char* a2 = last ? nA : cA + (size_t)(t + 2) * kstep; const char* b2 = last ? nB : cB + (size_t)(t + 2) * kstep;
            const char* a3 = a2 + kstep; const char* b3 = b2 + kstep;
            if (last && has_next) S.a_ready(nxt);
            if constexpr (SP2) {
            PG8_LDB(B0, 0, 0); PG8_LDB(B1, 0, 1); PG8_SCHED; PG8_LDA(At, 0, 0); PG8_STAGE(PG8_SA(1, 1), a1 + hstep, voffA);
            PG8_WAIT_V(8); PG8_WAIT_L(0); PG8_BAR; PG8_MMA(0, 0, At, B0); PG8_MMA(0, 1, At, B1); PG8_BAR; PG8_SCHED;
            PG8_LDA(At, 0, 1); PG8_STAGE(PG8_SB(0, 0), b2, voffB); PG8_STAGE(PG8_SB(0, 1), b2 + hstep, voffB); PG8_STAGE(PG8_SA(0, 0), a2, voffA);
            PG8_WAIT_V(8); PG8_WAIT_L(0); PG8_BAR; PG8_MMA(1, 0, At, B0); PG8_MMA(1, 1, At, B1); PG8_BAR; PG8_SCHED;
            PG8_LDB(B0, 1, 0); PG8_LDB(B1, 1, 1); PG8_SCHED; PG8_LDA(At, 1, 0); PG8_STAGE(PG8_SA(0, 1), a2 + hstep, voffA);
            PG8_WAIT_V(8); PG8_WAIT_L(0); PG8_BAR; PG8_MMA(0, 0, At, B0); PG8_MMA(0, 1, At, B1); PG8_BAR; PG8_SCHED;
            PG8_LDA(At, 1, 1); PG8_STAGE(PG8_SB(1, 0), b3, voffB); PG8_STAGE(PG8_SB(1, 1), b3 + hstep, voffB); PG8_STAGE(PG8_SA(1, 0), a3, voffA);
            PG8_WAIT_V(8); PG8_WAIT_L(0); PG8_BAR; PG8_MMA(1, 0, At, B0); PG8_MMA(1, 1, At, B1); PG8_BAR; PG8_SCHED;
            } else {
            PG8_LDB(B0, 0, 0); PG8_SCHED; PG8_LDA(At, 0, 0); PG8_STAGE(PG8_SA(1, 1), a1 + hstep, voffA);
            PG8_WAIT_L(8); PG8_BAR; PG8_WAIT_L(0); PG8_MMA(0, 0, At, B0); PG8_BAR; PG8_SCHED;
            PG8_LDB(B1, 0, 1); PG8_STAGE(PG8_SB(0, 0), b2, voffB);
            PG8_BAR; PG8_WAIT_L(0); PG8_MMA(0, 1, At, B1); PG8_BAR;
            PG8_LDA(At, 0, 1); PG8_STAGE(PG8_SA(0, 0), a2, voffA);
            PG8_BAR; PG8_WAIT_L(0); PG8_MMA(1, 0, At, B0); PG8_BAR; PG8_SCHED;
            PG8_STAGE(PG8_SB(0, 1), b2 + hstep, voffB);
            PG8_WAIT_V(6); PG8_BAR; PG8_MMA(1, 1, At, B1); PG8_BAR;
            PG8_LDB(B0, 1, 0); PG8_SCHED; PG8_LDA(At, 1, 0); PG8_STAGE(PG8_SA(0, 1), a2 + hstep, voffA);
            PG8_WAIT_L(8); PG8_BAR; PG8_WAIT_L(0); PG8_MMA(0, 0, At, B0); PG8_BAR; PG8_SCHED;
            PG8_LDB(B1, 1, 1); PG8_STAGE(PG8_SB(1, 0), b3, voffB);
            PG8_BAR; PG8_WAIT_L(0); PG8_MMA(0, 1, At, B1); PG8_BAR;
            PG8_LDA(At, 1, 1); PG8_STAGE(PG8_SA(1, 0), a3, voffA);
            PG8_BAR; PG8_WAIT_L(0); PG8_MMA(1, 0, At, B0); PG8_BAR; PG8_SCHED;
            PG8_STAGE(PG8_SB(1, 1), b3 + hstep, voffB);
            PG8_WAIT_V(6); PG8_BAR; PG8_MMA(1, 1, At, B1); PG8_BAR;
            }
        }
        if constexpr (ALIGN_EPI) { if (wr == 0) PG8_BAR; }
        if constexpr (!Epi::AFTER_DRAIN) { E(acc, cur, wr, wc, fr, fq); S.done(cur); }
        if (!has_next) break;
#pragma unroll
        for (int a = 0; a < 2; ++a)
#pragma unroll
            for (int b = 0; b < 2; ++b)
#pragma unroll
                for (int m = 0; m < 4; ++m)
#pragma unroll
                    for (int n = 0; n < 2; ++n) acc[a][b][m][n] = (f32x4){0.f, 0.f, 0.f, 0.f};
        cur = nxt; cA = nA; cB = nB; ++ui;
        if constexpr (ALIGN_EPI) { if (wr == 1) PG8_BAR; }
    }
    PG8_WAIT_V(0);
    if constexpr (!ALIGN_EPI) { if (wr == 0) PG8_BAR; }
    PG8_BAR;
    if constexpr (Epi::AFTER_DRAIN) { E.fused(acc, cur, wr, wc, fr, fq, lds, wid, lane); S.done(cur); }
#undef PG8_SA
#undef PG8_SB
#undef PG8_STAGE
#undef PG8_LDA
#undef PG8_LDB
#undef PG8_MMA
#undef PG8_WAIT_V
#undef PG8_WAIT_L
#undef PG8_BAR
#undef PG8_SCHED
}
}
#define LAS __attribute__((address_space(3)))
typedef unsigned short bf16;
typedef float f32x4 __attribute__((ext_vector_type(4)));
typedef unsigned u32x4 __attribute__((ext_vector_type(4)));
typedef unsigned u32x2 __attribute__((ext_vector_type(2)));
typedef short bf16x8 __attribute__((ext_vector_type(8)));
typedef short s16x4 __attribute__((ext_vector_type(4)));
#define LDS_WAIT() asm volatile("s_waitcnt lgkmcnt(0)" ::: "memory")

constexpr int D = 1024, FF = 2816, SEQ = 8192, MP = 16384, NSMP = 128, MR = 16512, MPAD = 16640;
constexpr int NWAVES = 8, NTHREADS = 512, LDS_BYTES = 147456;
#ifndef N_LAUNCH_PER_PHASE
#define N_LAUNCH_PER_PHASE 0
#endif
enum { I_XP = 0, I_XS, I_SCONV, I_CK, I_CV, I_GF1, I_W1G, I_W1U, I_W1D, I_GMIX, I_GF2, I_W2G, I_W2U, I_W2D, I_WINA, I_CONVW, I_WOUTA, I_GKV, I_WKV, I_GKN, I_WQ, I_GQN, I_SINKS, I_WO, N_IN };
constexpr size_t O_YP = 0, O_YS = 16777216, O_CONVP = 16908288, O_KP = 16916480, O_VP = 16982016, O_CONVS = 17047552, O_KS = 17571840, O_VS = 21766144, O_END = 25960448;
constexpr size_t MiB = 1u << 20;
constexpr size_t WS_SSQ = 0;
constexpr size_t SZ_WGU = (size_t)2 * FF * D * 2, SZ_WD = (size_t)D * FF * 2;
constexpr size_t WS_WGU = 1 * MiB;
constexpr size_t WS_WD = WS_WGU + 8 * SZ_WGU;
constexpr size_t WS_WIN = WS_WD + 8 * SZ_WD;
constexpr size_t WS_WOUT = WS_WIN + 2 * (size_t)3 * D * D * 2;
constexpr size_t WS_WKV = WS_WOUT + 2 * (size_t)D * D * 2;
constexpr size_t WS_WQ = WS_WKV + (size_t)512 * D * 2;
constexpr size_t WS_WO = WS_WQ + 2 * (size_t)D * D * 2;
constexpr size_t WS_XB = WS_WO + 2 * (size_t)D * D * 2;
constexpr size_t SZ_ACT = (size_t)MPAD * D * 2;
constexpr size_t WS_H = WS_XB + SZ_ACT;
constexpr size_t WS_KB = WS_H + (size_t)MPAD * FF * 2;
constexpr size_t WS_VT = WS_KB + (size_t)MP * 256 * 2;
constexpr size_t WS_END = WS_VT + (size_t)MP * 256 * 2;
static_assert(2 * SZ_ACT <= (size_t)MPAD * FF * 2, "overlays fit in H");

struct Args { const float* in[N_IN]; float* out; unsigned char* ws; int ph_lo, ph_hi; };
typedef const __attribute__((address_space(4))) Args* ArgsP;

__device__ __forceinline__ unsigned f2bf(float f) { unsigned u = __builtin_bit_cast(unsigned, f); return (u + 0x7fffu + ((u >> 16) & 1u)) >> 16; }
__device__ __forceinline__ unsigned pk2(float lo, float hi) { return f2bf(lo) | (f2bf(hi) << 16); }
__device__ __forceinline__ float bf2f(unsigned short b) { return __builtin_bit_cast(float, (unsigned)b << 16); }
__device__ __forceinline__ float bflo(unsigned w) { return __builtin_bit_cast(float, w << 16); }
__device__ __forceinline__ float bfhi(unsigned w) { return __builtin_bit_cast(float, w & 0xffff0000u); }
__device__ __forceinline__ float wave_sum(float v) {
#pragma unroll
    for (int o = 1; o < 64; o <<= 1) v += __shfl_xor(v, o);
    return v;
}
__device__ __forceinline__ float wave_max(float v) {
#pragma unroll
    for (int o = 1; o < 64; o <<= 1) v = fmaxf(v, __shfl_xor(v, o));
    return v;
}

__device__ __forceinline__ int rowmap(int mode, int n) {
    if (mode == 0) return n;
    if (mode == 1) return ((n >> 7) << 8) + (n & 127);
    if (mode == 2) return ((n >> 7) << 8) + 128 + (n & 127);
    if (mode == 3) {
        if (n < 1024) return 2048 + n;
        const int j = (n - 1024) & 1023; return ((j >> 7) << 8) + ((n >= 2048) ? 128 : 0) + (j & 127);
    }
    return (n & ~255) + (((n & 63) >> 5) << 7) + (((n >> 6) & 3) << 5) + (n & 31);
}
struct Job { const float* src; bf16* dst; const float* g; int K, N, mode; };
__device__ __forceinline__ Job get_job(ArgsP a, int j) {
    Job J; unsigned char* ws = a->ws;
    if (j < 24) {
        const int l = j / 6, r = j % 6, f = r / 3, t = r % 3;
        if (t < 2) { J.src = a->in[(f ? I_W2G : I_W1G) + t] + (size_t)l * D * FF; J.K = D; J.N = FF; J.dst = (bf16*)(ws + WS_WGU + (size_t)(2 * l + f) * SZ_WGU);
            J.g = a->in[f ? I_GF2 : I_GF1] + l * D; J.mode = 1 + t; }
        else { J.src = a->in[f ? I_W2D : I_W1D] + (size_t)l * FF * D; J.K = FF; J.N = D; J.dst = (bf16*)(ws + WS_WD + (size_t)(2 * l + f) * SZ_WD); J.g = nullptr; J.mode = 0; }
    } else if (j < 28) {
        const int i = (j - 24) >> 1, t = (j - 24) & 1;
        if (t == 0) { J.src = a->in[I_WINA] + (size_t)i * D * 3 * D; J.K = D; J.N = 3 * D; J.dst = (bf16*)(ws + WS_WIN + (size_t)i * 3 * D * D * 2); J.g = a->in[I_GMIX] + i * D; J.mode = 3; }
        else { J.src = a->in[I_WOUTA] + (size_t)i * D * D; J.K = D; J.N = D; J.dst = (bf16*)(ws + WS_WOUT + (size_t)i * D * D * 2); J.g = nullptr; J.mode = 0; }
    } else if (j == 28) {
        J.src = a->in[I_WKV]; J.K = D; J.N = 512; J.dst = (bf16*)(ws + WS_WKV); J.g = a->in[I_GKV]; J.mode = 4;
    } else {
        const int i = (j - 29) >> 1, t = (j - 29) & 1;
        if (t == 0) { J.src = a->in[I_WQ] + (size_t)i * D * D; J.K = D; J.N = D; J.dst = (bf16*)(ws + WS_WQ + (size_t)i * D * D * 2); J.g = a->in[I_GMIX] + (2 + i) * D; J.mode = 4; }
        else { J.src = a->in[I_WO] + (size_t)i * D * D; J.K = D; J.N = D; J.dst = (bf16*)(ws + WS_WO + (size_t)i * D * D * 2); J.g = nullptr; J.mode = 0; }
    }
    return J;
}
constexpr int NJOBS = 33;
__device__ __forceinline__ void transpose_item(const Job& J, LAS float* scr, int item, int lane) {
    const int nblk = J.N / 32, kb = item / nblk, nb = item % nblk, k0 = 64 * kb, n0 = 32 * nb;
#pragma unroll 8
    for (int i = 0; i < 32; ++i) { const int kk = 2 * i + (lane >> 5); float w = J.src[(size_t)(k0 + kk) * J.N + n0 + (lane & 31)]; if (J.g) w *= J.g[k0 + kk]; scr[kk * 33 + (lane & 31)] = w; }
    LDS_WAIT();
    const int c = lane & 7;
#pragma unroll
    for (int j = 0; j < 4; ++j) { const int n = (lane >> 3) + 8 * j; const LAS float* s = scr + (8 * c) * 33 + n;
        u32x4 o; o.x = pk2(s[0 * 33], s[1 * 33]); o.y = pk2(s[2 * 33], s[3 * 33]); o.z = pk2(s[4 * 33], s[5 * 33]); o.w = pk2(s[6 * 33], s[7 * 33]);
        *(u32x4*)(J.dst + (size_t)rowmap(J.mode, n0 + n) * J.K + k0 + 8 * c) = o; }
    LDS_WAIT();
}
__device__ __forceinline__ void prologue(ArgsP a, LAS unsigned char* lds, int gw, int ngw, int lane, int wave) {
    LAS float* scr = (LAS float*)(lds + wave * 16384);
    int base = 0;
    for (int j = 0; j < NJOBS; ++j) {
        const Job J = get_job(a, j); const int nitems = (J.K / 64) * (J.N / 32);
        int first = gw - (base % ngw); if (first < 0) first += ngw;
        for (int it = first; it < nitems; it += ngw) transpose_item(J, scr, it, lane);
        base += nitems;
    }
    float* X = a->out; bf16* XB = (bf16*)(a->ws + WS_XB); float* ssq = (float*)(a->ws + WS_SSQ);
    for (int m = gw; m < MPAD; m += ngw) {
        u32x2* o8 = (u32x2*)(XB + (size_t)m * D) + lane;
        if (m < MR) {
            const float* src = (m < MP) ? a->in[I_XP] + (size_t)m * D : a->in[I_XS] + (size_t)(m - MP) * D;
            const f32x4* xr = (const f32x4*)src + lane; f32x4* xo = (f32x4*)(X + (size_t)m * D) + lane; float s = 0.f;
#pragma unroll
            for (int j = 0; j < 4; ++j) { const f32x4 v = xr[64 * j]; xo[64 * j] = v; s += (v[0] * v[0] + v[1] * v[1]) + (v[2] * v[2] + v[3] * v[3]);
                u32x2 w; w.x = pk2(v[0], v[1]); w.y = pk2(v[2], v[3]); o8[64 * j] = w; }
            s = wave_sum(s); if (lane == 0) ssq[m] = s;
        } else {
#pragma unroll
            for (int j = 0; j < 4; ++j) o8[64 * j] = (u32x2){0u, 0u};
            if (lane == 0) ssq[m] = 0.f;
        }
    }
    const int gt = gw * 64 + lane, ngt = ngw * 64;
    for (int i = gt; i < 12 * MPAD; i += ngt) ssq[MPAD + i] = 0.f;
    for (int i = gt; i < 2 * NSMP * 127 * 64; i += ngt) {
        const int which = i / (NSMP * 127 * 64), r = i % (NSMP * 127 * 64), b = r / (127 * 64), q = r % (127 * 64), jrow = q >> 6, c4 = q & 63;
        const f32x4 v = *((const f32x4*)(a->in[which ? I_CV : I_CK] + ((size_t)b * 128 + jrow + 1) * 256) + c4);
        *((f32x4*)(a->out + (which ? O_VS : O_KS) + ((size_t)b * 128 + jrow) * 256) + c4) = v;
    }
}

__device__ __forceinline__ void unpack8(const u32x4 w, float (&f)[8]) { f[0] = bflo(w.x); f[1] = bfhi(w.x); f[2] = bflo(w.y); f[3] = bfhi(w.y); f[4] = bflo(w.z); f[5] = bfhi(w.z); f[6] = bflo(w.w); f[7] = bfhi(w.w); }
__device__ __forceinline__ void conv_phase(ArgsP a, int layer, int gt, int ngt) {
    const bf16* CU = (const bf16*)(a->ws + WS_H); bf16* BZ = (bf16*)(a->ws + WS_H + SZ_ACT);
    const float* cw = a->in[I_CONVW] + (size_t)layer * 3 * D; const float* st = a->in[I_SCONV] + (size_t)layer * NSMP * 2 * D;
    float* convp = a->out + O_CONVP + (size_t)layer * 2 * 2 * D; float* convs = a->out + O_CONVS + (size_t)layer * NSMP * 2 * D;
    for (int idx = gt; idx < MR * 128; idx += ngt) {
        const int row = idx >> 7, c8 = (idx & 127) * 8;
        float b[8], c2[8], c1[8], c0[8];
        unpack8(*(const u32x4*)(BZ + (size_t)row * D + c8), b); unpack8(*(const u32x4*)(CU + (size_t)row * D + c8), c2);
        if (row < MP) {
            const int t = row & 8191;
            if (t >= 1) unpack8(*(const u32x4*)(CU + (size_t)(row - 1) * D + c8), c1); else { for (int e = 0; e < 8; ++e) c1[e] = 0.f; }
            if (t >= 2) unpack8(*(const u32x4*)(CU + (size_t)(row - 2) * D + c8), c0); else { for (int e = 0; e < 8; ++e) c0[e] = 0.f; }
            if (t >= 8190) { float* o = convp + ((size_t)(row >> 13) * 2 + (t - 8190)) * D + c8; *(f32x4*)o = (f32x4){c2[0], c2[1], c2[2], c2[3]}; *(f32x4*)(o + 4) = (f32x4){c2[4], c2[5], c2[6], c2[7]}; }
        } else {
            const int bs = row - MP; const float* s0 = st + ((size_t)bs * 2) * D + c8;
            const f32x4 a0 = *(const f32x4*)s0, a1 = *(const f32x4*)(s0 + 4), b0 = *(const f32x4*)(s0 + D), b1 = *(const f32x4*)(s0 + D + 4);
#pragma unroll
            for (int e = 0; e < 4; ++e) { c0[e] = a0[e]; c0[4 + e] = a1[e]; c1[e] = b0[e]; c1[4 + e] = b1[e]; }
            float* o = convs + ((size_t)bs * 2) * D + c8;
            *(f32x4*)o = b0; *(f32x4*)(o + 4) = b1; *(f32x4*)(o + D) = (f32x4){c2[0], c2[1], c2[2], c2[3]}; *(f32x4*)(o + D + 4) = (f32x4){c2[4], c2[5], c2[6], c2[7]};
        }
        const f32x4 w0a = *(const f32x4*)(cw + c8), w0b = *(const f32x4*)(cw + c8 + 4), w1a = *(const f32x4*)(cw + D + c8), w1b = *(const f32x4*)(cw + D + c8 + 4), w2a = *(const f32x4*)(cw + 2 * D + c8), w2b = *(const f32x4*)(cw + 2 * D + c8 + 4);
        float z[8];
#pragma unroll
        for (int e = 0; e < 4; ++e) { z[e] = b[e] * (w0a[e] * c0[e] + w1a[e] * c1[e] + w2a[e] * c2[e]); z[4 + e] = b[4 + e] * (w0b[e] * c0[4 + e] + w1b[e] * c1[4 + e] + w2b[e] * c2[4 + e]); }
        u32x4 w; w.x = pk2(z[0], z[1]); w.y = pk2(z[2], z[3]); w.z = pk2(z[4], z[5]); w.w = pk2(z[6], z[7]);
        *(u32x4*)(BZ + (size_t)row * D + c8) = w;
    }
}

constexpr int KROW = 144, VROW = 560, KL_BYTES = 272 * KROW, VT_OFF = 40960, VT_BYTES = 64 * VROW, SMP_OFF = 81920;
static_assert(KL_BYTES <= VT_OFF && VT_OFF + VT_BYTES <= SMP_OFF, "attention LDS map");
__device__ __forceinline__ void attn_phase(ArgsP a, int j, LAS unsigned char* lds, int tid, int lane, int wave, int bid, int G) {
    const bf16* Qb = (const bf16*)(a->ws + WS_H); bf16* Ob = (bf16*)(a->ws + WS_H + SZ_ACT);
    const bf16* Kb = (const bf16*)(a->ws + WS_KB); const bf16* Vt = (const bf16*)(a->ws + WS_VT);
    const float* sinks = a->in[I_SINKS] + j * 16;
    const int fr = lane & 15, fq = lane >> 4;
    for (int unit = bid; unit < 512; unit += G) {
        const int b = unit >> 8, kvh = (unit >> 6) & 3, qblk = unit & 63, t0 = qblk * 128;
        __syncthreads();
        for (int c = tid; c < 272 * 8; c += NTHREADS) { const int row = c >> 3, ch = c & 7, t = t0 - 128 + row;
            u32x4 v = (u32x4){0u, 0u, 0u, 0u}; if (row < 256 && t >= 0) v = *(const u32x4*)(Kb + ((size_t)b * SEQ + t) * 256 + kvh * 64 + ch * 8);
            *(LAS u32x4*)(lds + row * KROW + ch * 16) = v; }
        for (int c = tid; c < 64 * 34; c += NTHREADS) { const int d = c / 34, ch = c % 34, t = t0 - 128 + ch * 8;
            u32x4 v = (u32x4){0u, 0u, 0u, 0u}; if (ch < 32 && t >= 0) v = *(const u32x4*)(Vt + ((size_t)(b * 4 + kvh) * 64 + d) * SEQ + t);
            *(LAS u32x4*)(lds + VT_OFF + d * VROW + ch * 16) = v; }
        __syncthreads();
        const int head = kvh * 4 + (wave >> 1); const float sink = sinks[head];
        for (int qt = 0; qt < 4; ++qt) {
            const int q0 = (wave & 1) * 64 + qt * 16, cb = q0 >> 4;
            const size_t grow = (size_t)b * SEQ + t0 + q0 + fr;
            const bf16x8 qf0 = *(const bf16x8*)(Qb + grow * D + head * 64 + fq * 8), qf1 = *(const bf16x8*)(Qb + grow * D + head * 64 + 32 + fq * 8);
            f32x4 s[10];
#pragma unroll
            for (int c = 0; c < 10; ++c) {
                const LAS unsigned char* kp = lds + (16 * (cb + c) + fr) * KROW + fq * 16;
                f32x4 acc = (f32x4){0.f, 0.f, 0.f, 0.f};
                acc = __builtin_amdgcn_mfma_f32_16x16x32_bf16(*(const LAS bf16x8*)kp, qf0, acc, 0, 0, 0);
                acc = __builtin_amdgcn_mfma_f32_16x16x32_bf16(*(const LAS bf16x8*)(kp + 64), qf1, acc, 0, 0, 0);
                s[c] = acc;
            }
            const int qi = q0 + fr; float mx = -INFINITY;
#pragma unroll
            for (int c = 0; c < 10; ++c)
#pragma unroll
                for (int i = 0; i < 4; ++i) { const int kj = 16 * (cb + c) + 4 * fq + i; const bool ok = (kj >= qi + 1) && (kj <= qi + 128) && (qblk > 0 || kj >= 128);
                    s[c][i] = ok ? s[c][i] : -INFINITY; mx = fmaxf(mx, s[c][i]); }
            mx = fmaxf(mx, __shfl_xor(mx, 16)); mx = fmaxf(mx, __shfl_xor(mx, 32)); mx = fmaxf(mx, sink);
            float sum = 0.f;
#pragma unroll
            for (int c = 0; c < 10; ++c)
#pragma unroll
                for (int i = 0; i < 4; ++i) { const float p = __expf(s[c][i] - mx); s[c][i] = p; sum += p; }
            sum += __shfl_xor(sum, 16); sum += __shfl_xor(sum, 32);
            const float inv = 1.0f / (sum + __expf(sink - mx));
            bf16x8 pb[5];
#pragma unroll
            for (int pp = 0; pp < 5; ++pp) { u32x4 w; w.x = pk2(s[2 * pp][0], s[2 * pp][1]); w.y = pk2(s[2 * pp][2], s[2 * pp][3]); w.z = pk2(s[2 * pp + 1][0], s[2 * pp + 1][1]); w.w = pk2(s[2 * pp + 1][2], s[2 * pp + 1][3]);
                pb[pp] = __builtin_bit_cast(bf16x8, w); }
#pragma unroll
            for (int dt = 0; dt < 4; ++dt) {
                f32x4 o = (f32x4){0.f, 0.f, 0.f, 0.f};
#pragma unroll
                for (int pp = 0; pp < 5; ++pp) {
                    const LAS unsigned char* vp = lds + VT_OFF + (16 * dt + fr) * VROW + (16 * (cb + 2 * pp) + 4 * fq) * 2;
                    const u32x2 lo = *(const LAS u32x2*)vp, hi = *(const LAS u32x2*)(vp + 32);
                    const u32x4 av = (u32x4){lo.x, lo.y, hi.x, hi.y};
                    o = __builtin_amdgcn_mfma_f32_16x16x32_bf16(__builtin_bit_cast(bf16x8, av), pb[pp], o, 0, 0, 0);
                }
                o = o * inv; u32x2 w; w.x = pk2(o[0], o[1]); w.y = pk2(o[2], o[3]);
                *(u32x2*)(Ob + grow * D + head * 64 + 16 * dt + 4 * fq) = w;
            }
        }
    }
    __syncthreads();
    LAS float* wq = (LAS float*)(lds + SMP_OFF + wave * 1024); LAS float* wsc = wq + 64;
    for (int task = bid * NWAVES + wave; task < NSMP * 16; task += G * NWAVES) {
        const int b = task >> 4, h = task & 15, kvh = h >> 2; const float sink = sinks[h];
        const size_t qoff = (size_t)(MP + b) * D + h * 64;
        wq[lane] = bf2f(Qb[qoff + lane]);
        LDS_WAIT();
        const int sub = lane >> 4, dq = lane & 15;
        const f32x4 q4 = *(const LAS f32x4*)(wq + 4 * dq);
        const float* ks = a->out + O_KS + (size_t)b * 128 * 256 + kvh * 64; const float* vs = a->out + O_VS + (size_t)b * 128 * 256 + kvh * 64;
        for (int it = 0; it < 32; ++it) { const int key = it * 4 + sub; const f32x4 k4 = *(const f32x4*)(ks + (size_t)key * 256 + 4 * dq);
            float p = (q4[0] * k4[0] + q4[1] * k4[1]) + (q4[2] * k4[2] + q4[3] * k4[3]);
            p += __shfl_xor(p, 1); p += __shfl_xor(p, 2); p += __shfl_xor(p, 4); p += __shfl_xor(p, 8);
            if (dq == 0) wsc[key] = p; }
        LDS_WAIT();
        const float s0 = wsc[lane], s1 = wsc[lane + 64];
        const float mx = fmaxf(wave_max(fmaxf(s0, s1)), sink);
        const float p0 = __expf(s0 - mx), p1 = __expf(s1 - mx);
        const float inv = 1.0f / (wave_sum(p0 + p1) + __expf(sink - mx));
        LDS_WAIT();
        wsc[lane] = p0; wsc[lane + 64] = p1;
        LDS_WAIT();
        float o = 0.f;
#pragma unroll 8
        for (int key = 0; key < 128; ++key) o += wsc[key] * vs[(size_t)key * 256 + lane];
        Ob[qoff + lane] = (bf16)f2bf(o * inv);
        LDS_WAIT();
    }
}
#define RLX_AGENT __ATOMIC_RELAXED, __HIP_MEMORY_SCOPE_AGENT
constexpr size_t WS_BAR = 896 * 1024;
constexpr int MISC_OFF = 131072 + 64;
#define XB_TMO      128
#define XB_XCNT(j)  (256  + 64 * (j))
#define XB_XSUB(j)  (1280 + 64 * (j))
#define XB_XGEN(j)  (2304 + 64 * (j))
#define XB_TOP      3328
#define XB_TOPGEN   3392
#define XCD_BAR_WORDS 3456
#define XB_SPIN_CAP (1u << 18)

__device__ __forceinline__ unsigned xb_ld(unsigned* p)              { return __hip_atomic_load(p, __ATOMIC_RELAXED, __HIP_MEMORY_SCOPE_AGENT); }
__device__ __forceinline__ unsigned xb_add(unsigned* p, unsigned v) { return __hip_atomic_fetch_add(p, v, __ATOMIC_RELAXED, __HIP_MEMORY_SCOPE_AGENT); }
__device__ __forceinline__ unsigned xb_xcc_id() { return (unsigned)__builtin_amdgcn_s_getreg((3 << 11) | 20) & 0xFu; }
#define XB_SPIN(cond, bar) do { unsigned _sp = 0; while (cond) { __builtin_amdgcn_s_sleep(1); \
    if ((++_sp & 255u) == 0u) { if (xb_ld(&(bar)[XB_TMO])) break; if (_sp > XB_SPIN_CAP) { atomicAdd(&(bar)[XB_TMO], 1u); break; } } } } while (0)

struct XcdBarrier {
    unsigned* bar; unsigned x;
    volatile LAS unsigned* st;
};

__device__ __forceinline__ XcdBarrier xcd_barrier_post(unsigned* bar, volatile LAS unsigned* st) {
    XcdBarrier b; b.bar = bar; b.x = xb_xcc_id(); b.st = st;
    if (threadIdx.x == 0) (void)xb_add(&bar[XB_XCNT(b.x)], 1u);
    return b;
}
__device__ __forceinline__ void xcd_barrier_complete(unsigned* bar, unsigned x, unsigned& nloc, unsigned& nx) {
    const unsigned G = gridDim.x * gridDim.y * gridDim.z;
    unsigned sum, cnt, mine, sp = 0u;
    for (;;) {
        sum = 0u; cnt = 0u; mine = 0u;
#pragma unroll
        for (unsigned j = 0; j < 16; ++j) { const unsigned c = xb_ld(&bar[XB_XCNT(j)]); sum += c; cnt += (c > 0u) ? 1u : 0u; mine = (j == x) ? c : mine; }
        if (sum == G) break;
        __builtin_amdgcn_s_sleep(1);
        if ((++sp & 255u) == 0u) { if (xb_ld(&bar[XB_TMO])) break; if (sp > XB_SPIN_CAP) { atomicAdd(&bar[XB_TMO], 1u); break; } }
    }
    nloc = mine > 0u ? mine : 1u; nx = cnt > 0u ? cnt : 1u;
}

__device__ __forceinline__ void xcd_barrier(const XcdBarrier& b) {
    asm volatile("s_waitcnt vmcnt(0)" ::: "memory");
    __syncthreads();
    if (threadIdx.x == 0) {
        unsigned* bar = b.bar;
        __builtin_amdgcn_s_waitcnt(0);
        unsigned nloc = b.st[0], nx = b.st[1];
        if (nloc == 0u) { xcd_barrier_complete(bar, b.x, nloc, nx); b.st[0] = nloc; b.st[1] = nx; }
        const unsigned old = xb_add(&bar[XB_XSUB(b.x)], 1u);
        const unsigned gen = old / nloc;
        if (old + 1u == (gen + 1u) * nloc) {
            __builtin_amdgcn_fence(__ATOMIC_RELEASE, "agent");
            asm volatile("s_waitcnt vmcnt(0)" ::: "memory");
            const unsigned og = xb_add(&bar[XB_TOP], 1u);
            const unsigned tg = og / nx;
            if (og + 1u == (tg + 1u) * nx) xb_add(&bar[XB_TOPGEN], 1u);
            else XB_SPIN(xb_ld(&bar[XB_TOPGEN]) == tg, bar);
            __builtin_amdgcn_fence(__ATOMIC_ACQUIRE, "agent");
            xb_add(&bar[XB_XGEN(b.x)], 1u);
            asm volatile("s_waitcnt vmcnt(0)" ::: "memory");
        } else {
            XB_SPIN(xb_ld(&bar[XB_XGEN(b.x)]) == gen, bar);
            __builtin_amdgcn_fence(__ATOMIC_ACQUIRE, "agent");
            asm volatile("s_waitcnt vmcnt(0)" ::: "memory");
        }
    }
    __syncthreads();
}

#ifndef KMASK
#define KMASK 511
#endif
constexpr int NSTEPS = 30;
template <class Epi>
__device__ __forceinline__ void run_gemm(int tid, int bid, int G, LAS unsigned char* lds, const bf16* A, const bf16* Bt, int M, int N, int K, const Epi& E) {
    pg8::Gemm g{A, Bt, M, N, K}; pg8::StaticOrder S; S.init(M, N, G, bid);
    pg8::gemm_phase<Epi, pg8::StaticOrder, true, true>(tid, lds, g, S, E);
}
__global__ void __launch_bounds__(NTHREADS, 2) yoco_fwd(Args a) {
    extern __shared__ __attribute__((aligned(16))) unsigned char lds_raw[];
    LAS unsigned char* lds = (LAS unsigned char*)lds_raw;
    cg::grid_group grid = cg::this_grid();
    const int ph_hi = a.ph_hi;
    if (threadIdx.x < 64) ((volatile LAS unsigned*)(lds + 131072))[threadIdx.x] = 0u;
    __syncthreads();
    XcdBarrier bar; bar.bar = (unsigned*)(a.ws + WS_BAR); bar.x = 0; bar.st = (volatile LAS unsigned*)(lds + MISC_OFF);
    if (a.ph_lo > 0) bar = xcd_barrier_post((unsigned*)(a.ws + WS_BAR), (volatile LAS unsigned*)(lds + MISC_OFF));
    for (int s = a.ph_lo; s < ph_hi; ++s) {
        ArgsP ap = (ArgsP)__builtin_amdgcn_kernarg_segment_ptr(); asm volatile("" : "+s"(ap));
        int tid = threadIdx.x; asm volatile("" : "+v"(tid));
        int bid = blockIdx.x, G = gridDim.x; asm volatile("" : "+s"(bid), "+s"(G));
        const int lane = tid & 63, wave = __builtin_amdgcn_readfirstlane(tid >> 6);
        const int gw = bid * NWAVES + wave, ngw = G * NWAVES, gt = bid * NTHREADS + tid, ngt = G * NTHREADS;
        unsigned char* ws = ap->ws;
        float* ssq = (float*)(ws + WS_SSQ); float* X = ap->out; bf16* XB = (bf16*)(ws + WS_XB); bf16* H = (bf16*)(ws + WS_H);
        bf16* CUQ = (bf16*)(ws + WS_H); bf16* BZO = (bf16*)(ws + WS_H + SZ_ACT);
        int kind, l = 0, f = 0;
        if (s == 0) kind = 0;
        else if (s == 15) kind = 9;
        else { const int r = (s < 15) ? s - 1 : s - 2; l = r / 7; const int jj = r % 7;
            if (jj == 0) { kind = 1; f = 0; } else if (jj == 1) { kind = 2; f = 0; } else if (jj == 5) { kind = 1; f = 1; } else if (jj == 6) { kind = 2; f = 1; }
            else kind = (l < 2 ? 3 : 6) + (jj - 2); }
        if (kind == 0) { if (bid == 0) for (int i = tid; i < XCD_BAR_WORDS; i += NTHREADS) __hip_atomic_store((unsigned*)(ws + WS_BAR) + i, 0u, RLX_AGENT); }
        if (kind == 0 && (KMASK & 1)) prologue(ap, lds, gw, ngw, lane, wave);
        else if (kind == 1 && (KMASK & 2)) {
            pg8::EpiSwiGLU E{H, ssq + (size_t)(3 * l + 2 * f) * MPAD};
            run_gemm(tid, bid, G, lds, XB, (const bf16*)(ws + WS_WGU + (size_t)(2 * l + f) * SZ_WGU), MPAD, 2 * FF, D, E);
        } else if (kind == 2 && (KMASK & 4)) {
            pg8::EpiResid E{X, XB, ssq + (size_t)(3 * l + 2 * f + 1) * MPAD, 0.5f};
            run_gemm(tid, bid, G, lds, H, (const bf16*)(ws + WS_WD + (size_t)(2 * l + f) * SZ_WD), MPAD, D, FF, E);
        } else if (kind == 3 && (KMASK & 8)) {
            pg8::EpiInProj E{CUQ, BZO, ssq + (size_t)(3 * l + 1) * MPAD};
            run_gemm(tid, bid, G, lds, XB, (const bf16*)(ws + WS_WIN + (size_t)l * 3 * D * D * 2), MPAD, 3 * D, D, E);
        } else if (kind == 4 && (KMASK & 16)) conv_phase(ap, l, gt, ngt);
        else if ((kind == 5 || kind == 8) && (KMASK & 32)) {
            pg8::EpiResid E{X, XB, ssq + (size_t)(3 * l + 2) * MPAD, 1.0f};
            const bf16* Bt = (kind == 5) ? (const bf16*)(ws + WS_WOUT + (size_t)l * D * D * 2) : (const bf16*)(ws + WS_WO + (size_t)(l - 2) * D * D * 2);
            run_gemm(tid, bid, G, lds, BZO, Bt, MPAD, D, D, E);
        } else if (kind == 6 && (KMASK & 64)) {
            pg8::EpiQ E{CUQ, ssq + (size_t)(3 * l + 1) * MPAD, ap->in[I_GQN] + (l - 2) * 64};
            run_gemm(tid, bid, G, lds, XB, (const bf16*)(ws + WS_WQ + (size_t)(l - 2) * D * D * 2), MPAD, D, D, E);
        } else if (kind == 7 && (KMASK & 128)) attn_phase(ap, l - 2, lds, tid, lane, wave, bid, G);
        else if (kind == 9 && (KMASK & 256)) {
            pg8::EpiKV E{(bf16*)(ws + WS_KB), (bf16*)(ws + WS_VT), ssq + (size_t)6 * MPAD, ap->in[I_GKN], ap->out + O_KP, ap->out + O_VP, ap->out + O_KS, ap->out + O_VS};
            run_gemm(tid, bid, G, lds, XB, (const bf16*)(ws + WS_WKV), MPAD, 512, D, E);
        }
        if (s + 1 < ph_hi) { if (s == 0) { grid.sync(); bar = xcd_barrier_post((unsigned*)(ws + WS_BAR), (volatile LAS unsigned*)(lds + MISC_OFF)); } else xcd_barrier(bar); }
    }
}

extern "C" void kernel_launch(void* const* d_in, const int* in_sizes, int n_in, void* d_out, int out_size, void* d_ws, size_t ws_size, hipStream_t stream) {
    static int grid = 0;
    if (grid == 0) {
        if (n_in != N_IN || (size_t)out_size != O_END || ws_size < WS_END) { fprintf(stderr, "kernel_launch: unexpected shapes: n_in %d out %d ws %zu (need %zu)\n", n_in, out_size, ws_size, (size_t)WS_END); grid = -1; return; }
        int dev = 0, cus = 0, per_cu = 0;
        hipGetDevice(&dev); hipDeviceGetAttribute(&cus, hipDeviceAttributeMultiprocessorCount, dev);
        if (hipFuncSetAttribute((const void*)yoco_fwd, hipFuncAttributeMaxDynamicSharedMemorySize, LDS_BYTES) != hipSuccess) { fprintf(stderr, "kernel_launch: hipFuncSetAttribute failed\n"); grid = -1; return; }
        if (hipOccupancyMaxActiveBlocksPerMultiprocessor(&per_cu, (const void*)yoco_fwd, NTHREADS, LDS_BYTES) != hipSuccess || per_cu < 1) { fprintf(stderr, "kernel_launch: occupancy query says %d\n", per_cu); per_cu = 1; }
        (void)hipGetLastError();
        grid = cus * 1;
    }
    if (grid < 0) return;
    Args a{};
    for (int i = 0; i < N_IN; ++i) a.in[i] = (const float*)d_in[i];
    a.out = (float*)d_out; a.ws = (unsigned char*)d_ws;
#if N_LAUNCH_PER_PHASE
    for (int s = 0; s < NSTEPS; ++s) { a.ph_lo = s; a.ph_hi = s + 1; hipLaunchKernelGGL(yoco_fwd, dim3(grid), dim3(NTHREADS), LDS_BYTES, stream, a); }
#else
    a.ph_lo = 0; a.ph_hi = NSTEPS;
    void* args[] = {&a};
    hipError_t e = hipLaunchCooperativeKernel((const void*)yoco_fwd, dim3(grid), dim3(NTHREADS), args, LDS_BYTES, stream);
    if (e != hipSuccess) fprintf(stderr, "kernel_launch: cooperative launch failed: %s (grid %d)\n", hipGetErrorString(e), grid);
#endif
}
```

```cpp
#include <hip/hip_runtime.h>
#include <hip/hip_cooperative_groups.h>
#include <cstdio>
#include <cstdint>
namespace cg = cooperative_groups;
#define N_LAUNCH_PER_PHASE 0
namespace pg8 {
#define PG8_LAS __attribute__((address_space(3)))
typedef unsigned short bf16_t;
typedef short bf16x8 __attribute__((ext_vector_type(8)));
typedef float f32x4 __attribute__((ext_vector_type(4)));
typedef unsigned u32x4 __attribute__((ext_vector_type(4)));
constexpr int BM = 256, BK = 64, HALF = 128, HTB = HALF * BK * 2  , STAGE_BYTES = 8 * HTB, NXCD = 8, WGM = 8;

__host__ __device__ __forceinline__ int lds_byte(int r, int c) { const int st = (r >> 4) * 2 + (c >> 5), rr = r & 15, cc = c & 31, ob = rr * 64 + cc * 2; return st * 1024 + (ob ^ (((ob >> 9) & 1) << 5)); }
__host__ __device__ __forceinline__ void stage_rc(int b, int& R, int& C) { const int st = b / 1024, sb = b % 1024, swz = sb ^ (((sb >> 9) & 1) << 5); R = (st >> 1) * 16 + swz / 64; C = (st & 1) * 32 + (swz % 64) / 2; }
__host__ __device__ __forceinline__ int perm32(int rho) { const int n = rho >> 4, i = rho & 15; return 8 * (i >> 2) + 4 * n + (i & 3); }

struct Unit { int pm, pn; };
struct Gemm { const bf16_t* A; const bf16_t* Bt; int M, N, K; };

struct StaticOrder {
    int nM, nN, nwg, G, c;
    __host__ __device__ void init(int M, int N, int G_, int c_) { nM = M / BM; nN = N / BM; nwg = nM * nN; G = G_; c = c_; }
    __host__ __device__ bool next(int i, Unit& u) const {
        const long L = (long)i * G + c; if (L >= nwg) return false;
        int wgid = (int)L; { const int q = nwg / NXCD, r = nwg % NXCD, xcd = wgid % NXCD, off = wgid / NXCD; wgid = (xcd < r ? xcd * (q + 1) : r * (q + 1) + (xcd - r) * q) + off; }
        const int nig = WGM * nN, gid = wgid / nig, fm = gid * WGM, gsz = (nM - fm) < WGM ? (nM - fm) : WGM;
        u.pm = fm + ((wgid % nig) % gsz); u.pn = (wgid % nig) / gsz; return true;
    }
    __device__ __forceinline__ void a_ready(const Unit&) const {}
    __device__ __forceinline__ void done(const Unit&) const {}
};

__device__ __forceinline__ unsigned cvt_pk_bf16(float lo, float hi) { unsigned r; asm volatile("v_cvt_pk_bf16_f32 %0, %1, %2" : "=v"(r) : "v"(lo), "v"(hi)); return r; }
#define PG8_EPI_CALL __device__ __forceinline__ void operator()(const f32x4 (&acc)[2][2][4][2], const Unit& u, int wr, int wc, int fr, int fq) const { \
        const int row0 = u.pm * BM + wr * 64 + fr; \
        _Pragma("unroll") for (int ai = 0; ai < 2; ++ai) _Pragma("unroll") for (int m = 0; m < 4; ++m) { \
            const f32x4 v[2][2] = {{acc[ai][0][m][0], acc[ai][0][m][1]}, {acc[ai][1][m][0], acc[ai][1][m][1]}}; \
            row(row0 + ai * HALF + m * 16, v, u.pn, wc, fr, fq); } }
typedef unsigned u32x2 __attribute__((ext_vector_type(2)));
constexpr int ROWS_REAL = 16512, ROWS_PROMPT = 16384, DM = 1024, DFF = 2816;
__device__ __forceinline__ float row_rstd(const float* ssq, int row) { return __builtin_amdgcn_rsqf(ssq[row] * (1.0f / 1024.0f) + 1e-6f); }
__device__ __forceinline__ float silu_mul(float g, float u) { return g * __builtin_amdgcn_rcpf(1.0f + __expf(-g)) * u; }

struct EpiSwiGLU {
    static constexpr bool PERM = true, AFTER_DRAIN = false;
    bf16_t* H; const float* ssq;
    __device__ __forceinline__ void row(const int row, const f32x4 (&v)[2][2], int pn, int wc, int fr, int fq) const {
        const float r = row_rstd(ssq, row);
        const f32x4 g0 = v[0][0] * r, g1 = v[0][1] * r, u0 = v[1][0] * r, u1 = v[1][1] * r;
        u32x4 w;
        w.x = cvt_pk_bf16(silu_mul(g0[0], u0[0]), silu_mul(g0[1], u0[1])); w.y = cvt_pk_bf16(silu_mul(g0[2], u0[2]), silu_mul(g0[3], u0[3]));
        w.z = cvt_pk_bf16(silu_mul(g1[0], u1[0]), silu_mul(g1[1], u1[1])); w.w = cvt_pk_bf16(silu_mul(g1[2], u1[2]), silu_mul(g1[3], u1[3]));
        *(u32x4*)(H + (size_t)row * DFF + pn * 128 + wc * 32 + 8 * fq) = w;
    }
    PG8_EPI_CALL
};

struct EpiResid {
    static constexpr bool PERM = false, AFTER_DRAIN = false;
    float* X; bf16_t* XB; float* ssq_next; float scale;
    __device__ __forceinline__ void row(const int row, const f32x4 (&v)[2][2], int pn, int wc, int fr, int fq) const {
        const int col0 = pn * BM + wc * 32 + 4 * fq; float ss = 0.f;
#pragma unroll
        for (int bj = 0; bj < 2; ++bj)
#pragma unroll
            for (int n = 0; n < 2; ++n) {
                const size_t off = (size_t)row * DM + col0 + bj * HALF + n * 16;
                f32x4 x = *(const f32x4*)(X + off); x = x + v[bj][n] * scale; *(f32x4*)(X + off) = x;
                u32x2 w; w.x = cvt_pk_bf16(x[0], x[1]); w.y = cvt_pk_bf16(x[2], x[3]); *(u32x2*)(XB + off) = w;
                ss += (x[0] * x[0] + x[1] * x[1]) + (x[2] * x[2] + x[3] * x[3]);
            }
        ss += __shfl_xor(ss, 16); ss += __shfl_xor(ss, 32);
        if (fq == 0) __hip_atomic_fetch_add(ssq_next + row, ss, __ATOMIC_RELAXED, __HIP_MEMORY_SCOPE_AGENT);
    }
    PG8_EPI_CALL
};

struct EpiInProj {
    static constexpr bool PERM = true, AFTER_DRAIN = false;
    bf16_t* CU; bf16_t* BZ; const float* ssq;
    __device__ __forceinline__ void row(const int row, const f32x4 (&v)[2][2], int pn, int wc, int fr, int fq) const {
        const float r = row_rstd(ssq, row);
        if (pn < 8) {
            const float r2 = r * r; const f32x4 p0 = v[0][0] * v[1][0] * r2, p1 = v[0][1] * v[1][1] * r2;
            u32x4 w; w.x = cvt_pk_bf16(p0[0], p0[1]); w.y = cvt_pk_bf16(p0[2], p0[3]); w.z = cvt_pk_bf16(p1[0], p1[1]); w.w = cvt_pk_bf16(p1[2], p1[3]);
            *(u32x4*)(CU + (size_t)row * DM + pn * 128 + wc * 32 + 8 * fq) = w;
        } else {
#pragma unroll
            for (int bj = 0; bj < 2; ++bj) {
                const f32x4 p0 = v[bj][0] * r, p1 = v[bj][1] * r;
                u32x4 w; w.x = cvt_pk_bf16(p0[0], p0[1]); w.y = cvt_pk_bf16(p0[2], p0[3]); w.z = cvt_pk_bf16(p1[0], p1[1]); w.w = cvt_pk_bf16(p1[2], p1[3]);
                *(u32x4*)(BZ + (size_t)row * DM + (pn - 8) * BM + bj * HALF + wc * 32 + 8 * fq) = w;
            }
        }
    }
    PG8_EPI_CALL
};

__device__ __forceinline__ void head_norm_rope(f32x4 (&v)[2][2], const f32x4 (&g)[2][2], int pos, int fq) {
    float ss = 0.f;
#pragma unroll
    for (int bj = 0; bj < 2; ++bj)
#pragma unroll
        for (int n = 0; n < 2; ++n) ss += (v[bj][n][0] * v[bj][n][0] + v[bj][n][1] * v[bj][n][1]) + (v[bj][n][2] * v[bj][n][2] + v[bj][n][3] * v[bj][n][3]);
    ss += __shfl_xor(ss, 16); ss += __shfl_xor(ss, 32);
    const float hr = __builtin_amdgcn_rsqf(ss * (1.0f / 64.0f) + 1e-6f);
#pragma unroll
    for (int bj = 0; bj < 2; ++bj)
#pragma unroll
        for (int n = 0; n < 2; ++n) v[bj][n] = v[bj][n] * hr * g[bj][n];
    const f32x4 x = v[0][0]; f32x4 o;
    const bool lo = (fq & 1) == 0;
    const float f0 = lo ? 1.0f : 0.001414213562373095f, f1 = lo ? 0.19392274474868576f : 0.0002742481756762073f;
    const float f2 = lo ? 0.03760603093086393f : 5.318295896944988e-05f, f3 = lo ? 0.007292664737217109f : 1.031338537721246e-05f;
    const float fr4[4] = {f0, f1, f2, f3};
#pragma unroll
    for (int e = 0; e < 4; ++e) {
        const float partner = __shfl_xor(x[e], 32);
        const float ang = (float)pos * fr4[e];
        double rev = (double)ang * 0.15915494309189535; rev -= __builtin_floor(rev);
        const float rv = (float)rev; const float s = __builtin_amdgcn_sinf(rv), c = __builtin_amdgcn_cosf(rv);
        o[e] = (fq < 2) ? (x[e] * c - partner * s) : (x[e] * c + partner * s);
    }
    v[0][0] = o;
}
__device__ __forceinline__ int row_pos(int row) { return row < ROWS_PROMPT ? (row & 8191) : 8192; }

struct EpiQ {
    static constexpr bool PERM = false, AFTER_DRAIN = false;
    bf16_t* Qb; const float* ssq; const float* gq;
    __device__ __forceinline__ void row(const int row, const f32x4 (&vin)[2][2], int pn, int wc, int fr, int fq) const {
        const int colh = pn * BM + 64 * wc + 4 * fq; const float r = row_rstd(ssq, row);
        f32x4 g[2][2], v[2][2];
#pragma unroll
        for (int bj = 0; bj < 2; ++bj)
#pragma unroll
            for (int n = 0; n < 2; ++n) { g[bj][n] = *(const f32x4*)(gq + 32 * bj + 16 * n + 4 * fq); v[bj][n] = vin[bj][n] * r; }
        head_norm_rope(v, g, row_pos(row), fq);
#pragma unroll
        for (int bj = 0; bj < 2; ++bj)
#pragma unroll
            for (int n = 0; n < 2; ++n) { const f32x4 x = v[bj][n] * 0.125f; u32x2 w; w.x = cvt_pk_bf16(x[0], x[1]); w.y = cvt_pk_bf16(x[2], x[3]);
                *(u32x2*)(Qb + (size_t)row * DM + colh + 32 * bj + 16 * n) = w; }
    }
    PG8_EPI_CALL
};

struct EpiKV {
    static constexpr bool PERM = false, AFTER_DRAIN = false;
    bf16_t* Kb; bf16_t* Vt; const float* ssq; const float* gk; float* ckp; float* cvp; float* cks; float* cvs;
    __device__ __forceinline__ void row(const int row, const f32x4 (&vin)[2][2], int pn, int wc, int fr, int fq) const {
        const int colh = 64 * wc + 4 * fq; const bool isk = (pn == 0); const float r = row_rstd(ssq, row);
        f32x4 g[2][2], v[2][2];
#pragma unroll
        for (int bj = 0; bj < 2; ++bj)
#pragma unroll
            for (int n = 0; n < 2; ++n) { g[bj][n] = *(const f32x4*)(gk + 32 * bj + 16 * n + 4 * fq); v[bj][n] = vin[bj][n] * r; }
        if (isk) head_norm_rope(v, g, row_pos(row), fq);
        float* cache = nullptr;
        if (row >= ROWS_PROMPT) cache = (isk ? cks : cvs) + ((size_t)(row - ROWS_PROMPT) * 128 + 127) * 256;
        else { const int t = row & 8191, b = row >> 13; if (t >= 8192 - 128) cache = (isk ? ckp : cvp) + ((size_t)b * 128 + (t - (8192 - 128))) * 256; }
#pragma unroll
        for (int bj = 0; bj < 2; ++bj)
#pragma unroll
            for (int n = 0; n < 2; ++n) {
                const f32x4 x = v[bj][n]; const int c = colh + 32 * bj + 16 * n;
                if (cache) *(f32x4*)(cache + c) = x;
                if (row < ROWS_PROMPT) {
                    if (isk) { u32x2 w; w.x = cvt_pk_bf16(x[0], x[1]); w.y = cvt_pk_bf16(x[2], x[3]); *(u32x2*)(Kb + (size_t)row * 256 + c) = w; }
                    else { const int t = row & 8191, b = row >> 13; const int d = 4 * fq + 32 * bj + 16 * n;
                        bf16_t* vp = Vt + ((size_t)(b * 4 + wc) * 64 + d) * 8192 + t;
                        const unsigned w0 = cvt_pk_bf16(x[0], x[1]), w1 = cvt_pk_bf16(x[2], x[3]);
                        vp[0] = (bf16_t)(w0 & 0xffffu); vp[8192] = (bf16_t)(w0 >> 16); vp[2 * 8192] = (bf16_t)(w1 & 0xffffu); vp[3 * 8192] = (bf16_t)(w1 >> 16); }
                }
            }
    }
    PG8_EPI_CALL
};
template <class Epi, class Sched, bool ALIGN_EPI = false, bool SP2 = false>
__device__ __forceinline__ void gemm_phase(const int tid, PG8_LAS unsigned char* lds, const Gemm g, const Sched& S, const Epi& E) {
    const int wid = __builtin_amdgcn_readfirstlane(tid >> 6), lane = tid & 63, wr = wid >> 2, wc = wid & 3, fr = lane & 15, fq = lane >> 4;
    const int K = g.K, nt = K / BK;
    unsigned voffA[2], voffB[2];
#pragma unroll
    for (int i = 0; i < 2; ++i) { int R, C; stage_rc(tid * 16 + i * 8192, R, C); const int Rb = Epi::PERM ? ((R & ~31) + perm32(R & 31)) : R;
        voffA[i] = (unsigned)(R * K + C) * 2u; voffB[i] = (unsigned)(Rb * K + C) * 2u; }
    const size_t kstep = (size_t)(BK * 2);
    const size_t hstep = (size_t)HALF * K * 2;
    const size_t tstep = 2 * hstep;
    const unsigned ldsw = (unsigned)wid * 1024u;
    const int aoff = lds_byte(wr * 64 + fr, fq * 8), boff = lds_byte(wc * 32 + fr, fq * 8);
#define PG8_SA(b, h) (((b) * 2 + (h)) * HTB)
#define PG8_SB(b, h) ((4 + (b) * 2 + (h)) * HTB)
#define PG8_STAGE(bufoff, gbase, voff) do { _Pragma("unroll") for (int _i = 0; _i < 2; ++_i) \
        __builtin_amdgcn_global_load_lds((const unsigned*)((const char*)(gbase) + (voff)[_i]), (PG8_LAS unsigned*)(lds + (bufoff) + ldsw + _i * 8192), 16, 0, 0); } while (0)
#define PG8_LDA(dst, b, h) do { _Pragma("unroll") for (int m = 0; m < 4; ++m) _Pragma("unroll") for (int k = 0; k < 2; ++k) dst[m][k] = *(const PG8_LAS bf16x8*)(lds + PG8_SA(b, h) + aoff + m * 2048 + k * 1024); } while (0)
#define PG8_LDB(dst, b, h) do { _Pragma("unroll") for (int n = 0; n < 2; ++n) _Pragma("unroll") for (int k = 0; k < 2; ++k) dst[n][k] = *(const PG8_LAS bf16x8*)(lds + PG8_SB(b, h) + boff + n * 2048 + k * 1024); } while (0)
#define PG8_MMA(ai, bj, At, Bt) do { __builtin_amdgcn_s_setprio(1); _Pragma("unroll") for (int m = 0; m < 4; ++m) _Pragma("unroll") for (int n = 0; n < 2; ++n) _Pragma("unroll") for (int k = 0; k < 2; ++k) \
        acc[ai][bj][m][n] = __builtin_amdgcn_mfma_f32_16x16x32_bf16(Bt[n][k], At[m][k], acc[ai][bj][m][n], 0, 0, 0); __builtin_amdgcn_s_setprio(0); } while (0)
#define PG8_WAIT_V(n) asm volatile("s_waitcnt vmcnt(" #n ")" ::: "memory")
#define PG8_WAIT_L(n) asm volatile("s_waitcnt lgkmcnt(" #n ")" ::: "memory")
#define PG8_BAR __builtin_amdgcn_s_barrier()
#define PG8_SCHED __builtin_amdgcn_sched_barrier(0)
    Unit cur, nxt; int ui = 0;
    if (!S.next(0, cur)) return;
    f32x4 acc[2][2][4][2];
#pragma unroll
    for (int a = 0; a < 2; ++a)
#pragma unroll
        for (int b = 0; b < 2; ++b)
#pragma unroll
            for (int m = 0; m < 4; ++m)
#pragma unroll
                for (int n = 0; n < 2; ++n) acc[a][b][m][n] = (f32x4){0.f, 0.f, 0.f, 0.f};
    bf16x8 At[4][2], B0[2][2], B1[2][2];
    const char* cA = (const char*)g.A + (size_t)cur.pm * tstep; const char* cB = (const char*)g.Bt + (size_t)cur.pn * tstep;
    S.a_ready(cur);
    if constexpr (SP2) {
        PG8_STAGE(PG8_SB(0, 0), cB, voffB); PG8_STAGE(PG8_SB(0, 1), cB + hstep, voffB); PG8_STAGE(PG8_SA(0, 0), cA, voffA); PG8_STAGE(PG8_SA(0, 1), cA + hstep, voffA);
        if (wr == 1) PG8_BAR;
        PG8_WAIT_V(2); PG8_BAR;
        PG8_STAGE(PG8_SB(1, 0), cB + kstep, voffB); PG8_STAGE(PG8_SA(1, 0), cA + kstep, voffA); PG8_STAGE(PG8_SB(1, 1), cB + hstep + kstep, voffB);
        PG8_WAIT_V(6); PG8_BAR;
    } else {
        PG8_STAGE(PG8_SB(0, 0), cB, voffB); PG8_STAGE(PG8_SA(0, 0), cA, voffA); PG8_STAGE(PG8_SB(0, 1), cB + hstep, voffB); PG8_STAGE(PG8_SA(0, 1), cA + hstep, voffA);
        if (wr == 1) PG8_BAR;
        PG8_WAIT_V(4); PG8_BAR;
        PG8_STAGE(PG8_SB(1, 0), cB + kstep, voffB); PG8_STAGE(PG8_SA(1, 0), cA + kstep, voffA); PG8_STAGE(PG8_SB(1, 1), cB + hstep + kstep, voffB);
        PG8_WAIT_V(6); PG8_BAR;
    }
    for (;;) {
        const bool has_next = S.next(ui + 1, nxt);
        const char* nA = has_next ? (const char*)g.A + (size_t)nxt.pm * tstep : cA; const char* nB = has_next ? (const char*)g.Bt + (size_t)nxt.pn * tstep : cB;
        for (int t = 0; t < nt; t += 2) {
            const bool last = (t == nt - 2);
            const char* a1 = cA + (size_t)(t + 1) * kstep;
            const char* a2 = last ? nA : cA + (size_t)(t + 2) * kstep; const char* b2 = last ? nB : cB + (size_t)(t + 2) * kstep;
            const char* a3 = a2 + kstep; const char* b3 = b2 + kstep;
            if (last && has_next) S.a_ready(nxt);
            if constexpr (SP2) {
            PG8_LDB(B0, 0, 0); PG8_LDB(B1, 0, 1); PG8_SCHED; PG8_LDA(At, 0, 0); PG8_STAGE(PG8_SA(1, 1), a1 + hstep, voffA);
            PG8_WAIT_V(8); PG8_WAIT_L(0); PG8_BAR; PG8_MMA(0, 0, At, B0); PG8_MMA(0, 1, At, B1); PG8_BAR; PG8_SCHED;
            PG8_LDA(At, 0, 1); PG8_STAGE(PG8_SB(0, 0), b2, voffB); PG8_STAGE(PG8_SB(0, 1), b2 + hstep, voffB); PG8_STAGE(PG8_SA(0, 0), a2, voffA);
            PG8_WAIT_V(8); PG8_WAIT_L(0); PG8_BAR; PG8_MMA(1, 0, At, B0); PG8_MMA(1, 1, At, B1); PG8_BAR; PG8_SCHED;
            PG8_LDB(B0, 1, 0); PG8_LDB(B1, 1, 1); PG8_SCHED; PG8_LDA(At, 1, 0); PG8_STAGE(PG8_SA(0, 1), a2 + hstep, voffA);
            PG8_WAIT_V(8); PG8_WAIT_L(0); PG8_BAR; PG8_MMA(0, 0, At, B0); PG8_MMA(0, 1, At, B1); PG8_BAR; PG8_SCHED;
            PG8_LDA(At, 1, 1); PG8_STAGE(PG8_SB(1, 0), b3, voffB); PG8_STAGE(PG8_SB(1, 1), b3 + hstep, voffB); PG8_STAGE(PG8_SA(1, 0), a3, voffA);
            PG8_WAIT_V(8); PG8_WAIT_L(0); PG8_BAR; PG8_MMA(1, 0, At, B0); PG8_MMA(1, 1, At, B1); PG8_BAR; PG8_SCHED;
            } else {
            PG8_LDB(B0, 0, 0); PG8_SCHED; PG8_LDA(At, 0, 0); PG8_STAGE(PG8_SA(1, 1), a1 + hstep, voffA);
            PG8_WAIT_L(8); PG8_BAR; PG8_WAIT_L(0); PG8_MMA(0, 0, At, B0); PG8_BAR; PG8_SCHED;
            PG8_LDB(B1, 0, 1); PG8_STAGE(PG8_SB(0, 0), b2, voffB);
            PG8_BAR; PG8_WAIT_L(0); PG8_MMA(0, 1, At, B1); PG8_BAR;
            PG8_LDA(At, 0, 1); PG8_STAGE(PG8_SA(0, 0), a2, voffA);
            PG8_BAR; PG8_WAIT_L(0); PG8_MMA(1, 0, At, B0); PG8_BAR; PG8_SCHED;
            PG8_STAGE(PG8_SB(0, 1), b2 + hstep, voffB);
            PG8_WAIT_V(6); PG8_BAR; PG8_MMA(1, 1, At, B1); PG8_BAR;
            PG8_LDB(B0, 1, 0); PG8_SCHED; PG8_LDA(At, 1, 0); PG8_STAGE(PG8_SA(0, 1), a2 + hstep, voffA);
            PG8_WAIT_L(8); PG8_BAR; PG8_WAIT_L(0); PG8_MMA(0, 0, At, B0); PG8_BAR; PG8_SCHED;
            PG8_LDB(B1, 1, 1); PG8_STAGE(PG8_SB(1, 0), b3, voffB);
            PG8_BAR; PG8_WAIT_L(0); PG8_MMA(0, 1, At, B1); PG8_BAR;
            PG8_LDA(At, 1, 1); PG8_STAGE(PG8_SA(1, 0), a3, voffA);
            PG8_BAR; PG8_WAIT_L(0); PG8_MMA(1, 0, At, B0); PG8_BAR; PG8_SCHED;
            PG8_STAGE(PG8_SB(1, 1), b3 + hstep, voffB);
            PG8_WAIT_V(6); PG8_BAR; PG8_MMA(1, 1, At, B1); PG8_BAR;
            }
        }
        if constexpr (ALIGN_EPI) { if (wr == 0) PG8_BAR; }
        if constexpr (!Epi::AFTER_DRAIN) { E(acc, cur, wr, wc, fr, fq); S.done(cur); }
        if (!has_next) break;
#pragma unroll
        for (int a = 0; a < 2; ++a)
#pragma unroll
            for (int b = 0; b < 2; ++b)
#pragma unroll
                for (int m = 0; m < 4; ++m)
#pragma unroll
                    for (int n = 0; n < 2; ++n) acc[a][b][m][n] = (f32x4){0.f, 0.f, 0.f, 0.f};
        cur = nxt; cA = nA; cB = nB; ++ui;
        if constexpr (ALIGN_EPI) { if (wr == 1) PG8_BAR; }
    }
    PG8_WAIT_V(0);
    if constexpr (!ALIGN_EPI) { if (wr == 0) PG8_BAR; }
    PG8_BAR;
    if constexpr (Epi::AFTER_DRAIN) { E.fused(acc, cur, wr, wc, fr, fq, lds, wid, lane); S.done(cur); }
#undef PG8_SA
#undef PG8_SB
#undef PG8_STAGE
#undef PG8_LDA
#undef PG8_LDB
#undef PG8_MMA
#undef PG8_WAIT_V
#undef PG8_WAIT_L
#undef PG8_BAR
#undef PG8_SCHED
}
}
#define LAS __attribute__((address_space(3)))
typedef unsigned short bf16;
typedef float f32x4 __attribute__((ext_vector_type(4)));
typedef unsigned u32x4 __attribute__((ext_vector_type(4)));
typedef unsigned u32x2 __attribute__((ext_vector_type(2)));
typedef short bf16x8 __attribute__((ext_vector_type(8)));
typedef short s16x4 __attribute__((ext_vector_type(4)));
#define LDS_WAIT() asm volatile("s_waitcnt lgkmcnt(0)" ::: "memory")

constexpr int D = 1024, FF = 2816, SEQ = 8192, MP = 16384, NSMP = 128, MR = 16512, MPAD = 16640;
constexpr int NWAVES = 8, NTHREADS = 512, LDS_BYTES = 147456;
#ifndef N_LAUNCH_PER_PHASE
#define N_LAUNCH_PER_PHASE 0
#endif
enum { I_XP = 0, I_XS, I_SCONV, I_CK, I_CV, I_GF1, I_W1G, I_W1U, I_W1D, I_GMIX, I_GF2, I_W2G, I_W2U, I_W2D, I_WINA, I_CONVW, I_WOUTA, I_GKV, I_WKV, I_GKN, I_WQ, I_GQN, I_SINKS, I_WO, N_IN };
constexpr size_t O_YP = 0, O_YS = 16777216, O_CONVP = 16908288, O_KP = 16916480, O_VP = 16982016, O_CONVS = 17047552, O_KS = 17571840, O_VS = 21766144, O_END = 25960448;
constexpr size_t MiB = 1u << 20;
constexpr size_t WS_SSQ = 0;
constexpr size_t SZ_WGU = (size_t)2 * FF * D * 2, SZ_WD = (size_t)D * FF * 2;
constexpr size_t WS_WGU = 1 * MiB;
constexpr size_t WS_WD = WS_WGU + 8 * SZ_WGU;
constexpr size_t WS_WIN = WS_WD + 8 * SZ_WD;
constexpr size_t WS_WOUT = WS_WIN + 2 * (size_t)3 * D * D * 2;
constexpr size_t WS_WKV = WS_WOUT + 2 * (size_t)D * D * 2;
constexpr size_t WS_WQ = WS_WKV + (size_t)512 * D * 2;
constexpr size_t WS_WO = WS_WQ + 2 * (size_t)D * D * 2;
constexpr size_t WS_XB = WS_WO + 2 * (size_t)D * D * 2;
constexpr size_t SZ_ACT = (size_t)MPAD * D * 2;
constexpr size_t WS_H = WS_XB + SZ_ACT;
constexpr size_t WS_KB = WS_H + (size_t)MPAD * FF * 2;
constexpr size_t WS_VT = WS_KB + (size_t)MP * 256 * 2;
constexpr size_t WS_END = WS_VT + (size_t)MP * 256 * 2;
static_assert(2 * SZ_ACT <= (size_t)MPAD * FF * 2, "overlays fit in H");

struct Args { const float* in[N_IN]; float* out; unsigned char* ws; int ph_lo, ph_hi; };
typedef const __attribute__((address_space(4))) Args* ArgsP;

__device__ __forceinline__ unsigned f2bf(float f) { unsigned u = __builtin_bit_cast(unsigned, f); return (u + 0x7fffu + ((u >> 16) & 1u)) >> 16; }
__device__ __forceinline__ unsigned pk2(float lo, float hi) { return f2bf(lo) | (f2bf(hi) << 16); }
__device__ __forceinline__ float bf2f(unsigned short b) { return __builtin_bit_cast(float, (unsigned)b << 16); }
__device__ __forceinline__ float bflo(unsigned w) { return __builtin_bit_cast(float, w << 16); }
__device__ __forceinline__ float bfhi(unsigned w) { return __builtin_bit_cast(float, w & 0xffff0000u); }
__device__ __forceinline__ float wave_sum(float v) {
#pragma unroll
    for (int o = 1; o < 64; o <<= 1) v += __shfl_xor(v, o);
    return v;
}
__device__ __forceinline__ float wave_max(float v) {
#pragma unroll
    for (int o = 1; o < 64; o <<= 1) v = fmaxf(v, __shfl_xor(v, o));
    return v;
}

__device__ __forceinline__ int rowmap(int mode, int n) {
    if (mode == 0) return n;
    if (mode == 1) return ((n >> 7) << 8) + (n & 127);
    if (mode == 2) return ((n >> 7) << 8) + 128 + (n & 127);
    if (mode == 3) {
        if (n < 1024) return 2048 + n;
        const int j = (n - 1024) & 1023; return ((j >> 7) << 8) + ((n >= 2048) ? 128 : 0) + (j & 127);
    }
    return (n & ~255) + (((n & 63) >> 5) << 7) + (((n >> 6) & 3) << 5) + (n & 31);
}
struct Job { const float* src; bf16* dst; const float* g; int K, N, mode; };
__device__ __forceinline__ Job get_job(ArgsP a, int j) {
    Job J; unsigned char* ws = a->ws;
    if (j < 24) {
        const int l = j / 6, r = j % 6, f = r / 3, t = r % 3;
        if (t < 2) { J.src = a->in[(f ? I_W2G : I_W1G) + t] + (size_t)l * D * FF; J.K = D; J.N = FF; J.dst = (bf16*)(ws + WS_WGU + (size_t)(2 * l + f) * SZ_WGU);
            J.g = a->in[f ? I_GF2 : I_GF1] + l * D; J.mode = 1 + t; }
        else { J.src = a->in[f ? I_W2D : I_W1D] + (size_t)l * FF * D; J.K = FF; J.N = D; J.dst = (bf16*)(ws + WS_WD + (size_t)(2 * l + f) * SZ_WD); J.g = nullptr; J.mode = 0; }
    } else if (j < 28) {
        const int i = (j - 24) >> 1, t = (j - 24) & 1;
        if (t == 0) { J.src = a->in[I_WINA] + (size_t)i * D * 3 * D; J.K = D; J.N = 3 * D; J.dst = (bf16*)(ws + WS_WIN + (size_t)i * 3 * D * D * 2); J.g = a->in[I_GMIX] + i * D; J.mode = 3; }
        else { J.src = a->in[I_WOUTA] + (size_t)i * D * D; J.K = D; J.N = D; J.dst = (bf16*)(ws + WS_WOUT + (size_t)i * D * D * 2); J.g = nullptr; J.mode = 0; }
    } else if (j == 28) {
        J.src = a->in[I_WKV]; J.K = D; J.N = 512; J.dst = (bf16*)(ws + WS_WKV); J.g = a->in[I_GKV]; J.mode = 4;
    } else {
        const int i = (j - 29) >> 1, t = (j - 29) & 1;
        if (t == 0) { J.src = a->in[I_WQ] + (size_t)i * D * D; J.K = D; J.N = D; J.dst = (bf16*)(ws + WS_WQ + (size_t)i * D * D * 2); J.g = a->in[I_GMIX] + (2 + i) * D; J.mode = 4; }
        else { J.src = a->in[I_WO] + (size_t)i * D * D; J.K = D; J.N = D; J.dst = (bf16*)(ws + WS_WO + (size_t)i * D * D * 2); J.g = nullptr; J.mode = 0; }
    }
    return J;
}
constexpr int NJOBS = 33;
__device__ __forceinline__ void transpose_item(const Job& J, LAS float* scr, int item, int lane) {
    const int nblk = J.N / 32, kb = item / nblk, nb = item % nblk, k0 = 64 * kb, n0 = 32 * nb;
#pragma unroll 8
    for (int i = 0; i < 32; ++i) { const int kk = 2 * i + (lane >> 5); float w = J.src[(size_t)(k0 + kk) * J.N + n0 + (lane & 31)]; if (J.g) w *= J.g[k0 + kk]; scr[kk * 33 + (lane & 31)] = w; }
    LDS_WAIT();
    const int c = lane & 7;
#pragma unroll
    for (int j = 0; j < 4; ++j) { const int n = (lane >> 3) + 8 * j; const LAS float* s = scr + (8 * c) * 33 + n;
        u32x4 o; o.x = pk2(s[0 * 33], s[1 * 33]); o.y = pk2(s[2 * 33], s[3 * 33]); o.z = pk2(s[4 * 33], s[5 * 33]); o.w = pk2(s[6 * 33], s[7 * 33]);
        *(u32x4*)(J.dst + (size_t)rowmap(J.mode, n0 + n) * J.K + k0 + 8 * c) = o; }
    LDS_WAIT();
}
__device__ __forceinline__ void prologue(ArgsP a, LAS unsigned char* lds, int gw, int ngw, int lane, int wave) {
    LAS float* scr = (LAS float*)(lds + wave * 16384);
    int base = 0;
    for (int j = 0; j < NJOBS; ++j) {
        const Job J = get_job(a, j); const int nitems = (J.K / 64) * (J.N / 32);
        int first = gw - (base % ngw); if (first < 0) first += ngw;
        for (int it = first; it < nitems; it += ngw) transpose_item(J, scr, it, lane);
        base += nitems;
    }
    float* X = a->out; bf16* XB = (bf16*)(a->ws + WS_XB); float* ssq = (float*)(a->ws + WS_SSQ);
    for (int m = gw; m < MPAD; m += ngw) {
        u32x2* o8 = (u32x2*)(XB + (size_t)m * D) + lane;
        if (m < MR) {
            const float* src = (m < MP) ? a->in[I_XP] + (size_t)m * D : a->in[I_XS] + (size_t)(m - MP) * D;
            const f32x4* xr = (const f32x4*)src + lane; f32x4* xo = (f32x4*)(X + (size_t)m * D) + lane; float s = 0.f;
#pragma unroll
            for (int j = 0; j < 4; ++j) { const f32x4 v = xr[64 * j]; xo[64 * j] = v; s += (v[0] * v[0] + v[1] * v[1]) + (v[2] * v[2] + v[3] * v[3]);
                u32x2 w; w.x = pk2(v[0], v[1]); w.y = pk2(v[2], v[3]); o8[64 * j] = w; }
            s = wave_sum(s); if (lane == 0) ssq[m] = s;
        } else {
#pragma unroll
            for (int j = 0; j < 4; ++j) o8[64 * j] = (u32x2){0u, 0u};
            if (lane == 0) ssq[m] = 0.f;
        }
    }
    const int gt = gw * 64 + lane, ngt = ngw * 64;
    for (int i = gt; i < 12 * MPAD; i += ngt) ssq[MPAD + i] = 0.f;
    for (int i = gt; i < 2 * NSMP * 127 * 64; i += ngt) {
        const int which = i / (NSMP * 127 * 64), r = i % (NSMP * 127 * 64), b = r / (127 * 64), q = r % (127 * 64), jrow = q >> 6, c4 = q & 63;
        const f32x4 v = *((const f32x4*)(a->in[which ? I_CV : I_CK] + ((size_t)b * 128 + jrow + 1) * 256) + c4);
        *((f32x4*)(a->out + (which ? O_VS : O_KS) + ((size_t)b * 128 + jrow) * 256) + c4) = v;
    }
}

__device__ __forceinline__ void unpack8(const u32x4 w, float (&f)[8]) { f[0] = bflo(w.x); f[1] = bfhi(w.x); f[2] = bflo(w.y); f[3] = bfhi(w.y); f[4] = bflo(w.z); f[5] = bfhi(w.z); f[6] = bflo(w.w); f[7] = bfhi(w.w); }
__device__ __forceinline__ void conv_phase(ArgsP a, int layer, int gt, int ngt) {
    const bf16* CU = (const bf16*)(a->ws + WS_H); bf16* BZ = (bf16*)(a->ws + WS_H + SZ_ACT);
    const float* cw = a->in[I_CONVW] + (size_t)layer * 3 * D; const float* st = a->in[I_SCONV] + (size_t)layer * NSMP * 2 * D;
    float* convp = a->out + O_CONVP + (size_t)layer * 2 * 2 * D; float* convs = a->out + O_CONVS + (size_t)layer * NSMP * 2 * D;
    for (int idx = gt; idx < MR * 128; idx += ngt) {
        const int row = idx >> 7, c8 = (idx & 127) * 8;
        float b[8], c2[8], c1[8], c0[8];
        unpack8(*(const u32x4*)(BZ + (size_t)row * D + c8), b); unpack8(*(const u32x4*)(CU + (size_t)row * D + c8), c2);
        if (row < MP) {
            const int t = row & 8191;
            if (t >= 1) unpack8(*(const u32x4*)(CU + (size_t)(row - 1) * D + c8), c1); else { for (int e = 0; e < 8; ++e) c1[e] = 0.f; }
            if (t >= 2) unpack8(*(const u32x4*)(CU + (size_t)(row - 2) * D + c8), c0); else { for (int e = 0; e < 8; ++e) c0[e] = 0.f; }
            if (t >= 8190) { float* o = convp + ((size_t)(row >> 13) * 2 + (t - 8190)) * D + c8; *(f32x4*)o = (f32x4){c2[0], c2[1], c2[2], c2[3]}; *(f32x4*)(o + 4) = (f32x4){c2[4], c2[5], c2[6], c2[7]}; }
        } else {
            const int bs = row - MP; const float* s0 = st + ((size_t)bs * 2) * D + c8;
            const f32x4 a0 = *(const f32x4*)s0, a1 = *(const f32x4*)(s0 + 4), b0 = *(const f32x4*)(s0 + D), b1 = *(const f32x4*)(s0 + D + 4);
#pragma unroll
            for (int e = 0; e < 4; ++e) { c0[e] = a0[e]; c0[4 + e] = a1[e]; c1[e] = b0[e]; c1[4 + e] = b1[e]; }
            float* o = convs + ((size_t)bs * 2) * D + c8;
            *(f32x4*)o = b0; *(f32x4*)(o + 4) = b1; *(f32x4*)(o + D) = (f32x4){c2[0], c2[1], c2[2], c2[3]}; *(f32x4*)(o + D + 4) = (f32x4){c2[4], c2[5], c2[6], c2[7]};
        }
        const f32x4 w0a = *(const f32x4*)(cw + c8), w0b = *(const f32x4*)(cw + c8 + 4), w1a = *(const f32x4*)(cw + D + c8), w1b = *(const f32x4*)(cw + D + c8 + 4), w2a = *(const f32x4*)(cw + 2 * D + c8), w2b = *(const f32x4*)(cw + 2 * D + c8 + 4);
        float z[8];
#pragma unroll
        for (int e = 0; e < 4; ++e) { z[e] = b[e] * (w0a[e] * c0[e] + w1a[e] * c1[e] + w2a[e] * c2[e]); z[4 + e] = b[4 + e] * (w0b[e] * c0[4 + e] + w1b[e] * c1[4 + e] + w2b[e] * c2[4 + e]); }
        u32x4 w; w.x = pk2(z[0], z[1]); w.y = pk2(z[2], z[3]); w.z = pk2(z[4], z[5]); w.w = pk2(z[6], z[7]);
        *(u32x4*)(BZ + (size_t)row * D + c8) = w;
    }
}

constexpr int KROW = 144, VROW = 560, KL_BYTES = 272 * KROW, VT_OFF = 40960, VT_BYTES = 64 * VROW, SMP_OFF = 81920;
static_assert(KL_BYTES <= VT_OFF && VT_OFF + VT_BYTES <= SMP_OFF, "attention LDS map");
__device__ __forceinline__ void attn_phase(ArgsP a, int j, LAS unsigned char* lds, int tid, int lane, int wave, int bid, int G) {
    const bf16* Qb = (const bf16*)(a->ws + WS_H); bf16* Ob = (bf16*)(a->ws + WS_H + SZ_ACT);
    const bf16* Kb = (const bf16*)(a->ws + WS_KB); const bf16* Vt = (const bf16*)(a->ws + WS_VT);
    const float* sinks = a->in[I_SINKS] + j * 16;
    const int fr = lane & 15, fq = lane >> 4;
    for (int unit = bid; unit < 512; unit += G) {
        const int b = unit >> 8, kvh = (unit >> 6) & 3, qblk = unit & 63, t0 = qblk * 128;
        __syncthreads();
        for (int c = tid; c < 272 * 8; c += NTHREADS) { const int row = c >> 3, ch = c & 7, t = t0 - 128 + row;
            u32x4 v = (u32x4){0u, 0u, 0u, 0u}; if (row < 256 && t >= 0) v = *(const u32x4*)(Kb + ((size_t)b * SEQ + t) * 256 + kvh * 64 + ch * 8);
            *(LAS u32x4*)(lds + row * KROW + ch * 16) = v; }
        for (int c = tid; c < 64 * 34; c += NTHREADS) { const int d = c / 34, ch = c % 34, t = t0 - 128 + ch * 8;
            u32x4 v = (u32x4){0u, 0u, 0u, 0u}; if (ch < 32 && t >= 0) v = *(const u32x4*)(Vt + ((size_t)(b * 4 + kvh) * 64 + d) * SEQ + t);
            *(LAS u32x4*)(lds + VT_OFF + d * VROW + ch * 16) = v; }
        __syncthreads();
        const int head = kvh * 4 + (wave >> 1); const float sink = sinks[head];
        for (int qt = 0; qt < 4; ++qt) {
            const int q0 = (wave & 1) * 64 + qt * 16, cb = q0 >> 4;
            const size_t grow = (size_t)b * SEQ + t0 + q0 + fr;
            const bf16x8 qf0 = *(const bf16x8*)(Qb + grow * D + head * 64 + fq * 8), qf1 = *(const bf16x8*)(Qb + grow * D + head * 64 + 32 + fq * 8);
            f32x4 s[10];
#pragma unroll
            for (int c = 0; c < 10; ++c) {
                const LAS unsigned char* kp = lds + (16 * (cb + c) + fr) * KROW + fq * 16;
                f32x4 acc = (f32x4){0.f, 0.f, 0.f, 0.f};
                acc = __builtin_amdgcn_mfma_f32_16x16x32_bf16(*(const LAS bf16x8*)kp, qf0, acc, 0, 0, 0);
                acc = __builtin_amdgcn_mfma_f32_16x16x32_bf16(*(const LAS bf16x8*)(kp + 64), qf1, acc, 0, 0, 0);
                s[c] = acc;
            }
            const int qi = q0 + fr; float mx = -INFINITY;
#pragma unroll
            for (int c = 0; c < 10; ++c)
#pragma unroll
                for (int i = 0; i < 4; ++i) { const int kj = 16 * (cb + c) + 4 * fq + i; const bool ok = (kj >= qi + 1) && (kj <= qi + 128) && (qblk > 0 || kj >= 128);
                    s[c][i] = ok ? s[c][i] : -INFINITY; mx = fmaxf(mx, s[c][i]); }
            mx = fmaxf(mx, __shfl_xor(mx, 16)); mx = fmaxf(mx, __shfl_xor(mx, 32)); mx = fmaxf(mx, sink);
            float sum = 0.f;
#pragma unroll
            for (int c = 0; c < 10; ++c)
#pragma unroll
                for (int i = 0; i < 4; ++i) { const float p = __expf(s[c][i] - mx); s[c][i] = p; sum += p; }
            sum += __shfl_xor(sum, 16); sum += __shfl_xor(sum, 32);
            const float inv = 1.0f / (sum + __expf(sink - mx));
            bf16x8 pb[5];
#pragma unroll
            for (int pp = 0; pp < 5; ++pp) { u32x4 w; w.x = pk2(s[2 * pp][0], s[2 * pp][1]); w.y = pk2(s[2 * pp][2], s[2 * pp][3]); w.z = pk2(s[2 * pp + 1][0], s[2 * pp + 1][1]); w.w = pk2(s[2 * pp + 1][2], s[2 * pp + 1][3]);
                pb[pp] = __builtin_bit_cast(bf16x8, w); }
#pragma unroll
            for (int dt = 0; dt < 4; ++dt) {
                f32x4 o = (f32x4){0.f, 0.f, 0.f, 0.f};
#pragma unroll
                for (int pp = 0; pp < 5; ++pp) {
                    const LAS unsigned char* vp = lds + VT_OFF + (16 * dt + fr) * VROW + (16 * (cb + 2 * pp) + 4 * fq) * 2;
                    const u32x2 lo = *(const LAS u32x2*)vp, hi = *(const LAS u32x2*)(vp + 32);
                    const u32x4 av = (u32x4){lo.x, lo.y, hi.x, hi.y};
                    o = __builtin_amdgcn_mfma_f32_16x16x32_bf16(__builtin_bit_cast(bf16x8, av), pb[pp], o, 0, 0, 0);
                }
                o = o * inv; u32x2 w; w.x = pk2(o[0], o[1]); w.y = pk2(o[2], o[3]);
                *(u32x2*)(Ob + grow * D + head * 64 + 16 * dt + 4 * fq) = w;
            }
        }
    }
    __syncthreads();
    LAS float* wq = (LAS float*)(lds + SMP_OFF + wave * 1024); LAS float* wsc = wq + 64;
    for (int task = bid * NWAVES + wave; task < NSMP * 16; task += G * NWAVES) {
        const int b = task >> 4, h = task & 15, kvh = h >> 2; const float sink = sinks[h];
        const size_t qoff = (size_t)(MP + b) * D + h * 64;
        wq[lane] = bf2f(Qb[qoff + lane]);
        LDS_WAIT();
        const int sub = lane >> 4, dq = lane & 15;
        const f32x4 q4 = *(const LAS f32x4*)(wq + 4 * dq);
        const float* ks = a->out + O_KS + (size_t)b * 128 * 256 + kvh * 64; const float* vs = a->out + O_VS + (size_t)b * 128 * 256 + kvh * 64;
        for (int it = 0; it < 32; ++it) { const int key = it * 4 + sub; const f32x4 k4 = *(const f32x4*)(ks + (size_t)key * 256 + 4 * dq);
            float p = (q4[0] * k4[0] + q4[1] * k4[1]) + (q4[2] * k4[2] + q4[3] * k4[3]);
            p += __shfl_xor(p, 1); p += __shfl_xor(p, 2); p += __shfl_xor(p, 4); p += __shfl_xor(p, 8);
            if (dq == 0) wsc[key] = p; }
        LDS_WAIT();
        const float s0 = wsc[lane], s1 = wsc[lane + 64];
        const float mx = fmaxf(wave_max(fmaxf(s0, s1)), sink);
        const float p0 = __expf(s0 - mx), p1 = __expf(s1 - mx);
        const float inv = 1.0f / (wave_sum(p0 + p1) + __expf(sink - mx));
        LDS_WAIT();
        wsc[lane] = p0; wsc[lane + 64] = p1;
        LDS_WAIT();
        float o = 0.f;
#pragma unroll 8
        for (int key = 0; key < 128; ++key) o += wsc[key] * vs[(size_t)key * 256 + lane];
        Ob[qoff + lane] = (bf16)f2bf(o * inv);
        LDS_WAIT();
    }
}
#define RLX_AGENT __ATOMIC_RELAXED, __HIP_MEMORY_SCOPE_AGENT
constexpr size_t WS_BAR = 896 * 1024;
constexpr int MISC_OFF = 131072 + 64;
#define XB_TMO      128
#define XB_XCNT(j)  (256  + 64 * (j))
#define XB_XSUB(j)  (1280 + 64 * (j))
#define XB_XGEN(j)  (2304 + 64 * (j))
#define XB_TOP      3328
#define XB_TOPGEN   3392
#define XCD_BAR_WORDS 3456
#define XB_SPIN_CAP (1u << 18)

__device__ __forceinline__ unsigned xb_ld(unsigned* p)              { return __hip_atomic_load(p, __ATOMIC_RELAXED, __HIP_MEMORY_SCOPE_AGENT); }
__device__ __forceinline__ unsigned xb_add(unsigned* p, unsigned v) { return __hip_atomic_fetch_add(p, v, __ATOMIC_RELAXED, __HIP_MEMORY_SCOPE_AGENT); }
__device__ __forceinline__ unsigned xb_xcc_id() { return (unsigned)__builtin_amdgcn_s_getreg((3 << 11) | 20) & 0xFu; }
#define XB_SPIN(cond, bar) do { unsigned _sp = 0; while (cond) { __builtin_amdgcn_s_sleep(1); \
    if ((++_sp & 255u) == 0u) { if (xb_ld(&(bar)[XB_TMO])) break; if (_sp > XB_SPIN_CAP) { atomicAdd(&(bar)[XB_TMO], 1u); break; } } } } while (0)

struct XcdBarrier {
    unsigned* bar; unsigned x;
    volatile LAS unsigned* st;
};

__device__ __forceinline__ XcdBarrier xcd_barrier_post(unsigned* bar, volatile LAS unsigned* st) {
    XcdBarrier b; b.bar = bar; b.x = xb_xcc_id(); b.st = st;
    if (threadIdx.x == 0) (void)xb_add(&bar[XB_XCNT(b.x)], 1u);
    return b;
}
__device__ __forceinline__ void xcd_barrier_complete(unsigned* bar, unsigned x, unsigned& nloc, unsigned& nx) {
    const unsigned G = gridDim.x * gridDim.y * gridDim.z;
    unsigned sum, cnt, mine, sp = 0u;
    for (;;) {
        sum = 0u; cnt = 0u; mine = 0u;
#pragma unroll
        for (unsigned j = 0; j < 16; ++j) { const unsigned c = xb_ld(&bar[XB_XCNT(j)]); sum += c; cnt += (c > 0u) ? 1u : 0u; mine = (j == x) ? c : mine; }
        if (sum == G) break;
        __builtin_amdgcn_s_sleep(1);
        if ((++sp & 255u) == 0u) { if (xb_ld(&bar[XB_TMO])) break; if (sp > XB_SPIN_CAP) { atomicAdd(&bar[XB_TMO], 1u); break; } }
    }
    nloc = mine > 0u ? mine : 1u; nx = cnt > 0u ? cnt : 1u;
}

__device__ __forceinline__ void xcd_barrier(const XcdBarrier& b) {
    asm volatile("s_waitcnt vmcnt(0)" ::: "memory");
    __syncthreads();
    if (threadIdx.x == 0) {
        unsigned* bar = b.bar;
        __builtin_amdgcn_s_waitcnt(0);
        unsigned nloc = b.st[0], nx = b.st[1];
        if (nloc == 0u) { xcd_barrier_complete(bar, b.x, nloc, nx); b.st[0] = nloc; b.st[1] = nx; }
        const unsigned old = xb_add(&bar[XB_XSUB(b.x)], 1u);
        const unsigned gen = old / nloc;
        if (old + 1u == (gen + 1u) * nloc) {
            __builtin_amdgcn_fence(__ATOMIC_RELEASE, "agent");
            asm volatile("s_waitcnt vmcnt(0)" ::: "memory");
            const unsigned og = xb_add(&bar[XB_TOP], 1u);
            const unsigned tg = og / nx;
            if (og + 1u == (tg + 1u) * nx) xb_add(&bar[XB_TOPGEN], 1u);
            else XB_SPIN(xb_ld(&bar[XB_TOPGEN]) == tg, bar);
            __builtin_amdgcn_fence(__ATOMIC_ACQUIRE, "agent");
            xb_add(&bar[XB_XGEN(b.x)], 1u);
            asm volatile("s_waitcnt vmcnt(0)" ::: "memory");
        } else {
            XB_SPIN(xb_ld(&bar[XB_XGEN(b.x)]) == gen, bar);
            __builtin_amdgcn_fence(__ATOMIC_ACQUIRE, "agent");
            asm volatile("s_waitcnt vmcnt(0)" ::: "memory");
        }
    }
    __syncthreads();
}

#ifndef KMASK
#define KMASK 511
#endif
constexpr int NSTEPS = 30;
template <class Epi>
__device__ __forceinline__ void run_gemm(int tid, int bid, int G, LAS unsigned char* lds, const bf16* A, const bf16* Bt, int M, int N, int K, const Epi& E) {
    pg8::Gemm g{A, Bt, M, N, K}; pg8::StaticOrder S; S.init(M, N, G, bid);
    pg8::gemm_phase<Epi, pg8::StaticOrder, true, true>(tid, lds, g, S, E);
}
template <class Epi>
__device__ __forceinline__ void sample_gemm(LAS unsigned char* lds, const bf16* A, const bf16* Bt, int N, int K, const Epi& E, int wg_first, int wg_count, int bid, int wave, int lane) {
    if (bid < wg_first) return;
    const int fr = lane & 15, fq = lane >> 4, ntasks = (N >> 8) * 32, kw = K >> 3;
    LAS float* part = (LAS float*)lds;
    for (int task = bid - wg_first; task < ntasks; task += wg_count) {
        const int rg = task & 7, wc = (task >> 3) & 3, pn = task >> 5;
        const bf16* ap = A + (size_t)(MP + 16 * rg + fr) * K + wave * kw + 8 * fq;
        const bf16* bp[2][2];
#pragma unroll
        for (int bj = 0; bj < 2; ++bj)
#pragma unroll
            for (int n = 0; n < 2; ++n) { const int wrow = pn * 256 + bj * 128 + wc * 32 + (Epi::PERM ? (8 * (fr >> 2) + 4 * n + (fr & 3)) : (16 * n + fr));
                bp[bj][n] = Bt + (size_t)wrow * K + wave * kw + 8 * fq; }
        f32x4 acc[2][2];
#pragma unroll
        for (int bj = 0; bj < 2; ++bj)
#pragma unroll
            for (int n = 0; n < 2; ++n) acc[bj][n] = (f32x4){0.f, 0.f, 0.f, 0.f};
#pragma unroll 4
        for (int k = 0; k < kw; k += 32) {
            const bf16x8 av = *(const bf16x8*)(ap + k);
#pragma unroll
            for (int bj = 0; bj < 2; ++bj)
#pragma unroll
                for (int n = 0; n < 2; ++n) acc[bj][n] = __builtin_amdgcn_mfma_f32_16x16x32_bf16(*(const bf16x8*)(bp[bj][n] + k), av, acc[bj][n], 0, 0, 0);
        }
#pragma unroll
        for (int bj = 0; bj < 2; ++bj)
#pragma unroll
            for (int n = 0; n < 2; ++n)
#pragma unroll
                for (int e = 0; e < 4; ++e) part[(wave * 16 + bj * 8 + n * 4 + e) * 64 + lane] = acc[bj][n][e];
        __syncthreads();
        if (wave == 0) {
            f32x4 v[2][2];
#pragma unroll
            for (int bj = 0; bj < 2; ++bj)
#pragma unroll
                for (int n = 0; n < 2; ++n)
#pragma unroll
                    for (int e = 0; e < 4; ++e) { float sacc = 0.f;
#pragma unroll
                        for (int w = 0; w < 8; ++w) sacc += part[(w * 16 + bj * 8 + n * 4 + e) * 64 + lane];
                        v[bj][n][e] = sacc; }
            E.row(MP + 16 * rg + fr, v, pn, wc, fr, fq);
        }
        __syncthreads();
    }
}
__global__ void __launch_bounds__(NTHREADS, 2) yoco_fwd(Args a) {
    extern __shared__ __attribute__((aligned(16))) unsigned char lds_raw[];
    LAS unsigned char* lds = (LAS unsigned char*)lds_raw;
    cg::grid_group grid = cg::this_grid();
    const int ph_hi = a.ph_hi;
    if (threadIdx.x < 64) ((volatile LAS unsigned*)(lds + 131072))[threadIdx.x] = 0u;
    __syncthreads();
    XcdBarrier bar; bar.bar = (unsigned*)(a.ws + WS_BAR); bar.x = 0; bar.st = (volatile LAS unsigned*)(lds + MISC_OFF);
    if (a.ph_lo > 0) bar = xcd_barrier_post((unsigned*)(a.ws + WS_BAR), (volatile LAS unsigned*)(lds + MISC_OFF));
    for (int s = a.ph_lo; s < ph_hi; ++s) {
        ArgsP ap = (ArgsP)__builtin_amdgcn_kernarg_segment_ptr(); asm volatile("" : "+s"(ap));
        int tid = threadIdx.x; asm volatile("" : "+v"(tid));
        int bid = blockIdx.x, G = gridDim.x; asm volatile("" : "+s"(bid), "+s"(G));
        const int lane = tid & 63, wave = __builtin_amdgcn_readfirstlane(tid >> 6);
        const int gw = bid * NWAVES + wave, ngw = G * NWAVES, gt = bid * NTHREADS + tid, ngt = G * NTHREADS;
        unsigned char* ws = ap->ws;
        float* ssq = (float*)(ws + WS_SSQ); float* X = ap->out; bf16* XB = (bf16*)(ws + WS_XB); bf16* H = (bf16*)(ws + WS_H);
        bf16* CUQ = (bf16*)(ws + WS_H); bf16* BZO = (bf16*)(ws + WS_H + SZ_ACT);
        int kind, l = 0, f = 0;
        if (s == 0) kind = 0;
        else if (s == 15) kind = 9;
        else { const int r = (s < 15) ? s - 1 : s - 2; l = r / 7; const int jj = r % 7;
            if (jj == 0) { kind = 1; f = 0; } else if (jj == 1) { kind = 2; f = 0; } else if (jj == 5) { kind = 1; f = 1; } else if (jj == 6) { kind = 2; f = 1; }
            else kind = (l < 2 ? 3 : 6) + (jj - 2); }
        if (kind == 0) { if (bid == 0) for (int i = tid; i < XCD_BAR_WORDS; i += NTHREADS) __hip_atomic_store((unsigned*)(ws + WS_BAR) + i, 0u, RLX_AGENT); }
        if (kind == 0 && (KMASK & 1)) prologue(ap, lds, gw, ngw, lane, wave);
        else if (kind == 1 && (KMASK & 2)) {
            pg8::EpiSwiGLU E{H, ssq + (size_t)(3 * l + 2 * f) * MPAD};
            const bf16* Bt = (const bf16*)(ws + WS_WGU + (size_t)(2 * l + f) * SZ_WGU);
            run_gemm(tid, bid, G, lds, XB, Bt, MP, 2 * FF, D, E);
            sample_gemm(lds, XB, Bt, 2 * FF, D, E, G / 2, G - G / 2, bid, wave, lane);
        } else if (kind == 2 && (KMASK & 4)) {
            pg8::EpiResid E{X, XB, ssq + (size_t)(3 * l + 2 * f + 1) * MPAD, 0.5f};
            const bf16* Bt = (const bf16*)(ws + WS_WD + (size_t)(2 * l + f) * SZ_WD);
            run_gemm(tid, bid, G, lds, H, Bt, MP, D, FF, E);
            sample_gemm(lds, H, Bt, D, FF, E, 0, G, bid, wave, lane);
        } else if (kind == 3 && (KMASK & 8)) {
            pg8::EpiInProj E{CUQ, BZO, ssq + (size_t)(3 * l + 1) * MPAD};
            const bf16* Bt = (const bf16*)(ws + WS_WIN + (size_t)l * 3 * D * D * 2);
            run_gemm(tid, bid, G, lds, XB, Bt, MP, 3 * D, D, E);
            sample_gemm(lds, XB, Bt, 3 * D, D, E, 0, G, bid, wave, lane);
        } else if (kind == 4 && (KMASK & 16)) conv_phase(ap, l, gt, ngt);
        else if ((kind == 5 || kind == 8) && (KMASK & 32)) {
            pg8::EpiResid E{X, XB, ssq + (size_t)(3 * l + 2) * MPAD, 1.0f};
            const bf16* Bt = (kind == 5) ? (const bf16*)(ws + WS_WOUT + (size_t)l * D * D * 2) : (const bf16*)(ws + WS_WO + (size_t)(l - 2) * D * D * 2);
            run_gemm(tid, bid, G, lds, BZO, Bt, MP, D, D, E);
            sample_gemm(lds, BZO, Bt, D, D, E, 0, G, bid, wave, lane);
        } else if (kind == 6 && (KMASK & 64)) {
            pg8::EpiQ E{CUQ, ssq + (size_t)(3 * l + 1) * MPAD, ap->in[I_GQN] + (l - 2) * 64};
            const bf16* Bt = (const bf16*)(ws + WS_WQ + (size_t)(l - 2) * D * D * 2);
            run_gemm(tid, bid, G, lds, XB, Bt, MP, D, D, E);
            sample_gemm(lds, XB, Bt, D, D, E, 0, G, bid, wave, lane);
        } else if (kind == 7 && (KMASK & 128)) attn_phase(ap, l - 2, lds, tid, lane, wave, bid, G);
        else if (kind == 9 && (KMASK & 256)) {
            pg8::EpiKV E{(bf16*)(ws + WS_KB), (bf16*)(ws + WS_VT), ssq + (size_t)6 * MPAD, ap->in[I_GKN], ap->out + O_KP, ap->out + O_VP, ap->out + O_KS, ap->out + O_VS};
            run_gemm(tid, bid, G, lds, XB, (const bf16*)(ws + WS_WKV), MP, 512, D, E);
            sample_gemm(lds, XB, (const bf16*)(ws + WS_WKV), 512, D, E, G / 2, G - G / 2, bid, wave, lane);
        }
        if (s + 1 < ph_hi) { if (s == 0) { grid.sync(); bar = xcd_barrier_post((unsigned*)(ws + WS_BAR), (volatile LAS unsigned*)(lds + MISC_OFF)); } else xcd_barrier(bar); }
    }
}

extern "C" void kernel_launch(void* const* d_in, const int* in_sizes, int n_in, void* d_out, int out_size, void* d_ws, size_t ws_size, hipStream_t stream) {
    static int grid = 0;
    if (grid == 0) {
        if (n_in != N_IN || (size_t)out_size != O_END || ws_size < WS_END) { fprintf(stderr, "kernel_launch: unexpected shapes: n_in %d out %d ws %zu (need %zu)\n", n_in, out_size, ws_size, (size_t)WS_END); grid = -1; return; }
        int dev = 0, cus = 0, per_cu = 0;
        hipGetDevice(&dev); hipDeviceGetAttribute(&cus, hipDeviceAttributeMultiprocessorCount, dev);
        if (hipFuncSetAttribute((const void*)yoco_fwd, hipFuncAttributeMaxDynamicSharedMemorySize, LDS_BYTES) != hipSuccess) { fprintf(stderr, "kernel_launch: hipFuncSetAttribute failed\n"); grid = -1; return; }
        if (hipOccupancyMaxActiveBlocksPerMultiprocessor(&per_cu, (const void*)yoco_fwd, NTHREADS, LDS_BYTES) != hipSuccess || per_cu < 1) { fprintf(stderr, "kernel_launch: occupancy query says %d\n", per_cu); per_cu = 1; }
        (void)hipGetLastError();
        grid = cus * 1;
    }
    if (grid < 0) return;
    Args a{};
    for (int i = 0; i < N_IN; ++i) a.in[i] = (const float*)d_in[i];
    a.out = (float*)d_out; a.ws = (unsigned char*)d_ws;
#if N_LAUNCH_PER_PHASE
    for (int s = 0; s < NSTEPS; ++s) { a.ph_lo = s; a.ph_hi = s + 1; hipLaunchKernelGGL(yoco_fwd, dim3(grid), dim3(NTHREADS), LDS_BYTES, stream, a); }
#else
    a.ph_lo = 0; a.ph_hi = NSTEPS;
    void* args[] = {&a};
    hipError_t e = hipLaunchCooperativeKernel((const void*)yoco_fwd, dim3(grid), dim3(NTHREADS), args, LDS_BYTES, stream);
    if (e != hipSuccess) fprintf(stderr, "kernel_launch: cooperative launch failed: %s (grid %d)\n", hipGetErrorString(e), grid);
#endif
}
```

```cpp
#include <hip/hip_runtime.h>
#include <hip/hip_cooperative_groups.h>
#include <cstdio>
#include <cstdint>
namespace cg = cooperative_groups;
#define N_LAUNCH_PER_PHASE 0
namespace pg8 {
#define PG8_LAS __attribute__((address_space(3)))
typedef unsigned short bf16_t;
typedef short bf16x8 __attribute__((ext_vector_type(8)));
typedef float f32x4 __attribute__((ext_vector_type(4)));
typedef unsigned u32x4 __attribute__((ext_vector_type(4)));
constexpr int BM = 256, BK = 64, HALF = 128, HTB = HALF * BK * 2  , STAGE_BYTES = 8 * HTB, NXCD = 8, WGM = 8;

__host__ __device__ __forceinline__ int lds_byte(int r, int c) { const int st = (r >> 4) * 2 + (c >> 5), rr = r & 15, cc = c & 31, ob = rr * 64 + cc * 2; return st * 1024 + (ob ^ (((ob >> 9) & 1) << 5)); }
__host__ __device__ __forceinline__ void stage_rc(int b, int& R, int& C) { const int st = b / 1024, sb = b % 1024, swz = sb ^ (((sb >> 9) & 1) << 5); R = (st >> 1) * 16 + swz / 64; C = (st & 1) * 32 + (swz % 64) / 2; }
__host__ __device__ __forceinline__ int perm32(int rho) { const int n = rho >> 4, i = rho & 15; return 8 * (i >> 2) + 4 * n + (i & 3); }

struct Unit { int pm, pn; };
struct Gemm { const bf16_t* A; const bf16_t* Bt; int M, N, K; };

struct StaticOrder {
    int nM, nN, nwg, G, c;
    __host__ __device__ void init(int M, int N, int G_, int c_) { nM = M / BM; nN = N / BM; nwg = nM * nN; G = G_; c = c_; }
    __host__ __device__ bool next(int i, Unit& u) const {
        const long L = (long)i * G + c; if (L >= nwg) return false;
        int wgid = (int)L; { const int q = nwg / NXCD, r = nwg % NXCD, xcd = wgid % NXCD, off = wgid / NXCD; wgid = (xcd < r ? xcd * (q + 1) : r * (q + 1) + (xcd - r) * q) + off; }
        const int nig = WGM * nN, gid = wgid / nig, fm = gid * WGM, gsz = (nM - fm) < WGM ? (nM - fm) : WGM;
        u.pm = fm + ((wgid % nig) % gsz); u.pn = (wgid % nig) / gsz; return true;
    }
    __device__ __forceinline__ void a_ready(const Unit&) const {}
    __device__ __forceinline__ void done(const Unit&) const {}
};

__device__ __forceinline__ unsigned cvt_pk_bf16(float lo, float hi) { unsigned r; asm volatile("v_cvt_pk_bf16_f32 %0, %1, %2" : "=v"(r) : "v"(lo), "v"(hi)); return r; }
#define PG8_EPI_CALL __device__ __forceinline__ void operator()(const f32x4 (&acc)[2][2][4][2], const Unit& u, int wr, int wc, int fr, int fq) const { \
        const int row0 = u.pm * BM + wr * 64 + fr; \
        _Pragma("unroll") for (int ai = 0; ai < 2; ++ai) _Pragma("unroll") for (int m = 0; m < 4; ++m) { \
            const f32x4 v[2][2] = {{acc[ai][0][m][0], acc[ai][0][m][1]}, {acc[ai][1][m][0], acc[ai][1][m][1]}}; \
            row(row0 + ai * HALF + m * 16, v, u.pn, wc, fr, fq); } }
typedef unsigned u32x2 __attribute__((ext_vector_type(2)));
constexpr int ROWS_REAL = 16512, ROWS_PROMPT = 16384, DM = 1024, DFF = 2816;
__device__ __forceinline__ float row_rstd(const float* ssq, int row) { return __builtin_amdgcn_rsqf(ssq[row] * (1.0f / 1024.0f) + 1e-6f); }
__device__ __forceinline__ float silu_mul(float g, float u) { return g * __builtin_amdgcn_rcpf(1.0f + __expf(-g)) * u; }

struct EpiSwiGLU {
    static constexpr bool PERM = true, AFTER_DRAIN = false;
    bf16_t* H; const float* ssq;
    __device__ __forceinline__ void row(const int row, const f32x4 (&v)[2][2], int pn, int wc, int fr, int fq) const {
        const float r = row_rstd(ssq, row);
        const f32x4 g0 = v[0][0] * r, g1 = v[0][1] * r, u0 = v[1][0] * r, u1 = v[1][1] * r;
        u32x4 w;
        w.x = cvt_pk_bf16(silu_mul(g0[0], u0[0]), silu_mul(g0[1], u0[1])); w.y = cvt_pk_bf16(silu_mul(g0[2], u0[2]), silu_mul(g0[3], u0[3]));
        w.z = cvt_pk_bf16(silu_mul(g1[0], u1[0]), silu_mul(g1[1], u1[1])); w.w = cvt_pk_bf16(silu_mul(g1[2], u1[2]), silu_mul(g1[3], u1[3]));
        *(u32x4*)(H + (size_t)row * DFF + pn * 128 + wc * 32 + 8 * fq) = w;
    }
    PG8_EPI_CALL
};

struct EpiResid {
    static constexpr bool PERM = false, AFTER_DRAIN = false;
    float* X; bf16_t* XB; float* ssq_next; float scale;
    __device__ __forceinline__ void row(const int row, const f32x4 (&v)[2][2], int pn, int wc, int fr, int fq) const {
        const int col0 = pn * BM + wc * 32 + 4 * fq; float ss = 0.f;
#pragma unroll
        for (int bj = 0; bj < 2; ++bj)
#pragma unroll
            for (int n = 0; n < 2; ++n) {
                const size_t off = (size_t)row * DM + col0 + bj * HALF + n * 16;
                f32x4 x = *(const f32x4*)(X + off); x = x + v[bj][n] * scale; *(f32x4*)(X + off) = x;
                u32x2 w; w.x = cvt_pk_bf16(x[0], x[1]); w.y = cvt_pk_bf16(x[2], x[3]); *(u32x2*)(XB + off) = w;
                ss += (x[0] * x[0] + x[1] * x[1]) + (x[2] * x[2] + x[3] * x[3]);
            }
        ss += __shfl_xor(ss, 16); ss += __shfl_xor(ss, 32);
        if (fq == 0) __hip_atomic_fetch_add(ssq_next + row, ss, __ATOMIC_RELAXED, __HIP_MEMORY_SCOPE_AGENT);
    }
    PG8_EPI_CALL
};

struct EpiInProj {
    static constexpr bool PERM = true, AFTER_DRAIN = false;
    bf16_t* CU; bf16_t* BZ; const float* ssq;
    __device__ __forceinline__ void row(const int row, const f32x4 (&v)[2][2], int pn, int wc, int fr, int fq) const {
        const float r = row_rstd(ssq, row);
        if (pn < 8) {
            const float r2 = r * r; const f32x4 p0 = v[0][0] * v[1][0] * r2, p1 = v[0][1] * v[1][1] * r2;
            u32x4 w; w.x = cvt_pk_bf16(p0[0], p0[1]); w.y = cvt_pk_bf16(p0[2], p0[3]); w.z = cvt_pk_bf16(p1[0], p1[1]); w.w = cvt_pk_bf16(p1[2], p1[3]);
            *(u32x4*)(CU + (size_t)row * DM + pn * 128 + wc * 32 + 8 * fq) = w;
        } else {
#pragma unroll
            for (int bj = 0; bj < 2; ++bj) {
                const f32x4 p0 = v[bj][0] * r, p1 = v[bj][1] * r;
                u32x4 w; w.x = cvt_pk_bf16(p0[0], p0[1]); w.y = cvt_pk_bf16(p0[2], p0[3]); w.z = cvt_pk_bf16(p1[0], p1[1]); w.w = cvt_pk_bf16(p1[2], p1[3]);
                *(u32x4*)(BZ + (size_t)row * DM + (pn - 8) * BM + bj * HALF + wc * 32 + 8 * fq) = w;
            }
        }
    }
    PG8_EPI_CALL
};

__device__ __forceinline__ void head_norm_rope(f32x4 (&v)[2][2], const f32x4 (&g)[2][2], int pos, int fq) {
    float ss = 0.f;
#pragma unroll
    for (int bj = 0; bj < 2; ++bj)
#pragma unroll
        for (int n = 0; n < 2; ++n) ss += (v[bj][n][0] * v[bj][n][0] + v[bj][n][1] * v[bj][n][1]) + (v[bj][n][2] * v[bj][n][2] + v[bj][n][3] * v[bj][n][3]);
    ss += __shfl_xor(ss, 16); ss += __shfl_xor(ss, 32);
    const float hr = __builtin_amdgcn_rsqf(ss * (1.0f / 64.0f) + 1e-6f);
#pragma unroll
    for (int bj = 0; bj < 2; ++bj)
#pragma unroll
        for (int n = 0; n < 2; ++n) v[bj][n] = v[bj][n] * hr * g[bj][n];
    const f32x4 x = v[0][0]; f32x4 o;
    const bool lo = (fq & 1) == 0;
    const float f0 = lo ? 1.0f : 0.001414213562373095f, f1 = lo ? 0.19392274474868576f : 0.0002742481756762073f;
    const float f2 = lo ? 0.03760603093086393f : 5.318295896944988e-05f, f3 = lo ? 0.007292664737217109f : 1.031338537721246e-05f;
    const float fr4[4] = {f0, f1, f2, f3};
#pragma unroll
    for (int e = 0; e < 4; ++e) {
        const float partner = __shfl_xor(x[e], 32);
        const float ang = (float)pos * fr4[e];
        double rev = (double)ang * 0.15915494309189535; rev -= __builtin_floor(rev);
        const float rv = (float)rev; const float s = __builtin_amdgcn_sinf(rv), c = __builtin_amdgcn_cosf(rv);
        o[e] = (fq < 2) ? (x[e] * c - partner * s) : (x[e] * c + partner * s);
    }
    v[0][0] = o;
}
__device__ __forceinline__ int row_pos(int row) { return row < ROWS_PROMPT ? (row & 8191) : 8192; }

struct EpiQ {
    static constexpr bool PERM = false, AFTER_DRAIN = false;
    bf16_t* Qb; const float* ssq; const float* gq;
    __device__ __forceinline__ void row(const int row, const f32x4 (&vin)[2][2], int pn, int wc, int fr, int fq) const {
        const int colh = pn * BM + 64 * wc + 4 * fq; const float r = row_rstd(ssq, row);
        f32x4 g[2][2], v[2][2];
#pragma unroll
        for (int bj = 0; bj < 2; ++bj)
#pragma unroll
            for (int n = 0; n < 2; ++n) { g[bj][n] = *(const f32x4*)(gq + 32 * bj + 16 * n + 4 * fq); v[bj][n] = vin[bj][n] * r; }
        head_norm_rope(v, g, row_pos(row), fq);
#pragma unroll
        for (int bj = 0; bj < 2; ++bj)
#pragma unroll
            for (int n = 0; n < 2; ++n) { const f32x4 x = v[bj][n] * 0.125f; u32x2 w; w.x = cvt_pk_bf16(x[0], x[1]); w.y = cvt_pk_bf16(x[2], x[3]);
                *(u32x2*)(Qb + (size_t)row * DM + colh + 32 * bj + 16 * n) = w; }
    }
    PG8_EPI_CALL
};

struct EpiKV {
    static constexpr bool PERM = false, AFTER_DRAIN = false;
    bf16_t* Kb; bf16_t* Vt; const float* ssq; const float* gk; float* ckp; float* cvp; float* cks; float* cvs;
    __device__ __forceinline__ void row(const int row, const f32x4 (&vin)[2][2], int pn, int wc, int fr, int fq) const {
        const int colh = 64 * wc + 4 * fq; const bool isk = (pn == 0); const float r = row_rstd(ssq, row);
        f32x4 g[2][2], v[2][2];
#pragma unroll
        for (int bj = 0; bj < 2; ++bj)
#pragma unroll
            for (int n = 0; n < 2; ++n) { g[bj][n] = *(const f32x4*)(gk + 32 * bj + 16 * n + 4 * fq); v[bj][n] = vin[bj][n] * r; }
        if (isk) head_norm_rope(v, g, row_pos(row), fq);
        float* cache = nullptr;
        if (row >= ROWS_PROMPT) cache = (isk ? cks : cvs) + ((size_t)(row - ROWS_PROMPT) * 128 + 127) * 256;
        else { const int t = row & 8191, b = row >> 13; if (t >= 8192 - 128) cache = (isk ? ckp : cvp) + ((size_t)b * 128 + (t - (8192 - 128))) * 256; }
#pragma unroll
        for (int bj = 0; bj < 2; ++bj)
#pragma unroll
            for (int n = 0; n < 2; ++n) {
                const f32x4 x = v[bj][n]; const int c = colh + 32 * bj + 16 * n;
                if (cache) *(f32x4*)(cache + c) = x;
                if (row < ROWS_PROMPT) {
                    if (isk) { u32x2 w; w.x = cvt_pk_bf16(x[0], x[1]); w.y = cvt_pk_bf16(x[2], x[3]); *(u32x2*)(Kb + (size_t)row * 256 + c) = w; }
                    else { const int t = row & 8191, b = row >> 13; const int d = 4 * fq + 32 * bj + 16 * n;
                        bf16_t* vp = Vt + ((size_t)(b * 4 + wc) * 64 + d) * 8192 + t;
                        const unsigned w0 = cvt_pk_bf16(x[0], x[1]), w1 = cvt_pk_bf16(x[2], x[3]);
                        vp[0] = (bf16_t)(w0 & 0xffffu); vp[8192] = (bf16_t)(w0 >> 16); vp[2 * 8192] = (bf16_t)(w1 & 0xffffu); vp[3 * 8192] = (bf16_t)(w1 >> 16); }
                }
            }
    }
    PG8_EPI_CALL
};
template <class Epi, class Sched, bool ALIGN_EPI = false, bool SP2 = false>
__device__ __forceinline__ void gemm_phase(const int tid, PG8_LAS unsigned char* lds, const Gemm g, const Sched& S, const Epi& E) {
    const int wid = __builtin_amdgcn_readfirstlane(tid >> 6), lane = tid & 63, wr = wid >> 2, wc = wid & 3, fr = lane & 15, fq = lane >> 4;
    const int K = g.K, nt = K / BK;
    unsigned voffA[2], voffB[2];
#pragma unroll
    for (int i = 0; i < 2; ++i) { int R, C; stage_rc(tid * 16 + i * 8192, R, C); const int Rb = Epi::PERM ? ((R & ~31) + perm32(R & 31)) : R;
        voffA[i] = (unsigned)(R * K + C) * 2u; voffB[i] = (unsigned)(Rb * K + C) * 2u; }
    const size_t kstep = (size_t)(BK * 2);
    const size_t hstep = (size_t)HALF * K * 2;
    const size_t tstep = 2 * hstep;
    const unsigned ldsw = (unsigned)wid * 1024u;
    const int aoff = lds_byte(wr * 64 + fr, fq * 8), boff = lds_byte(wc * 32 + fr, fq * 8);
#define PG8_SA(b, h) (((b) * 2 + (h)) * HTB)
#define PG8_SB(b, h) ((4 + (b) * 2 + (h)) * HTB)
#define PG8_STAGE(bufoff, gbase, voff) do { _Pragma("unroll") for (int _i = 0; _i < 2; ++_i) \
        __builtin_amdgcn_global_load_lds((const unsigned*)((const char*)(gbase) + (voff)[_i]), (PG8_LAS unsigned*)(lds + (bufoff) + ldsw + _i * 8192), 16, 0, 0); } while (0)
#define PG8_LDA(dst, b, h) do { _Pragma("unroll") for (int m = 0; m < 4; ++m) _Pragma("unroll") for (int k = 0; k < 2; ++k) dst[m][k] = *(const PG8_LAS bf16x8*)(lds + PG8_SA(b, h) + aoff + m * 2048 + k * 1024); } while (0)
#define PG8_LDB(dst, b, h) do { _Pragma("unroll") for (int n = 0; n < 2; ++n) _Pragma("unroll") for (int k = 0; k < 2; ++k) dst[n][k] = *(const PG8_LAS bf16x8*)(lds + PG8_SB(b, h) + boff + n * 2048 + k * 1024); } while (0)
#define PG8_MMA(ai, bj, At, Bt) do { __builtin_amdgcn_s_setprio(1); _Pragma("unroll") for (int m = 0; m < 4; ++m) _Pragma("unroll") for (int n = 0; n < 2; ++n) _Pragma("unroll") for (int k = 0; k < 2; ++k) \
        acc[ai][bj][m][n] = __builtin_amdgcn_mfma_f32_16x16x32_bf16(Bt[n][k], At[m][k], acc[ai][bj][m][n], 0, 0, 0); __builtin_amdgcn_s_setprio(0); } while (0)
#define PG8_WAIT_V(n) asm volatile("s_waitcnt vmcnt(" #n ")" ::: "memory")
#define PG8_WAIT_L(n) asm volatile("s_waitcnt lgkmcnt(" #n ")" ::: "memory")
#define PG8_BAR __builtin_amdgcn_s_barrier()
#define PG8_SCHED __builtin_amdgcn_sched_barrier(0)
    Unit cur, nxt; int ui = 0;
    if (!S.next(0, cur)) return;
    f32x4 acc[2][2][4][2];
#pragma unroll
    for (int a = 0; a < 2; ++a)
#pragma unroll
        for (int b = 0; b < 2; ++b)
#pragma unroll
            for (int m = 0; m < 4; ++m)
#pragma unroll
                for (int n = 0; n < 2; ++n) acc[a][b][m][n] = (f32x4){0.f, 0.f, 0.f, 0.f};
    bf16x8 At[4][2], B0[2][2], B1[2][2];
    const char* cA = (const char*)g.A + (size_t)cur.pm * tstep; const char* cB = (const char*)g.Bt + (size_t)cur.pn * tstep;
    S.a_ready(cur);
    if constexpr (SP2) {
        PG8_STAGE(PG8_SB(0, 0), cB, voffB); PG8_STAGE(PG8_SB(0, 1), cB + hstep, voffB); PG8_STAGE(PG8_SA(0, 0), cA, voffA); PG8_STAGE(PG8_SA(0, 1), cA + hstep, voffA);
        if (wr == 1) PG8_BAR;
        PG8_WAIT_V(2); PG8_BAR;
        PG8_STAGE(PG8_SB(1, 0), cB + kstep, voffB); PG8_STAGE(PG8_SA(1, 0), cA + kstep, voffA); PG8_STAGE(PG8_SB(1, 1), cB + hstep + kstep, voffB);
        PG8_WAIT_V(6); PG8_BAR;
    } else {
        PG8_STAGE(PG8_SB(0, 0), cB, voffB); PG8_STAGE(PG8_SA(0, 0), cA, voffA); PG8_STAGE(PG8_SB(0, 1), cB + hstep, voffB); PG8_STAGE(PG8_SA(0, 1), cA + hstep, voffA);
        if (wr == 1) PG8_BAR;
        PG8_WAIT_V(4); PG8_BAR;
        PG8_STAGE(PG8_SB(1, 0), cB + kstep, voffB); PG8_STAGE(PG8_SA(1, 0), cA + kstep, voffA); PG8_STAGE(PG8_SB(1, 1), cB + hstep + kstep, voffB);
        PG8_WAIT_V(6); PG8_BAR;
    }
    for (;;) {
        const bool has_next = S.next(ui + 1, nxt);
        const char* nA = has_next ? (const char*)g.A + (size_t)nxt.pm * tstep : cA; const char* nB = has_next ? (const char*)g.Bt + (size_t)nxt.pn * tstep : cB;
        for (int t = 0; t < nt; t += 2) {
            const bool last = (t == nt - 2);
            const char* a1 = cA + (size_t)(t + 1) * kstep;
            const char* a2 = last ? nA : cA + (size_t)(t + 2) * kstep; const char* b2 = last ? nB : cB + (size_t)(t + 2) * kstep;
            const char* a3 = a2 + kstep; const char* b3 = b2 + kstep;
            if (last && has_next) S.a_ready(nxt);
            if constexpr (SP2) {
            PG8_LDB(B0, 0, 0); PG8_LDB(B1, 0, 1); PG8_SCHED; PG8_LDA(At, 0, 0); PG8_STAGE(PG8_SA(1, 1), a1 + hstep, voffA);
            PG8_WAIT_V(8); PG8_WAIT_L(0); PG8_BAR; PG8_MMA(0, 0, At, B0); PG8_MMA(0, 1, At, B1); PG8_BAR; PG8_SCHED;
            PG8_LDA(At, 0, 1); PG8_STAGE(PG8_SB(0, 0), b2, voffB); PG8_STAGE(PG8_SB(0, 1), b2 + hstep, voffB); PG8_STAGE(PG8_SA(0, 0), a2, voffA);
            PG8_WAIT_V(8); PG8_WAIT_L(0); PG8_BAR; PG8_MMA(1, 0, At, B0); PG8_MMA(1, 1, At, B1); PG8_BAR; PG8_SCHED;
            PG8_LDB(B0, 1, 0); PG8_LDB(B1, 1, 1); PG8_SCHED; PG8_LDA(At, 1, 0); PG8_STAGE(PG8_SA(0, 1), a2 + hstep, voffA);
            PG8_WAIT_V(8); PG8_WAIT_L(0); PG8_BAR; PG8_MMA(0, 0, At, B0); PG8_MMA(0, 1, At, B1); PG8_BAR; PG8_SCHED;
            PG8_LDA(At, 1, 1); PG8_STAGE(PG8_SB(1, 0), b3, voffB); PG8_STAGE(PG8_SB(1, 1), b3 + hstep, voffB); PG8_STAGE(PG8_SA(1, 0), a3, voffA);
            PG8_WAIT_V(8); PG8_WAIT_L(0); PG8_BAR; PG8_MMA(1, 0, At, B0); PG8_MMA(1, 1, At, B1); PG8_BAR; PG8_SCHED;
            } else {
            PG8_LDB(B0, 0, 0); PG8_SCHED; PG8_LDA(At, 0, 0); PG8_STAGE(PG8_SA(1, 1), a1 + hstep, voffA);
            PG8_WAIT_L(8); PG8_BAR; PG8_WAIT_L(0); PG8_MMA(0, 0, At, B0); PG8_BAR; PG8_SCHED;
            PG8_LDB(B1, 0, 1); PG8_STAGE(PG8_SB(0, 0), b2, voffB);
            PG8_BAR; PG8_WAIT_L(0); PG8_MMA(0, 1, At, B1); PG8_BAR;
            PG8_LDA(At, 0, 1); PG8_STAGE(PG8_SA(0, 0), a2, voffA);
            PG8_BAR; PG8_WAIT_L(0); PG8_MMA(1, 0, At, B0); PG8_BAR; PG8_SCHED;
            PG8_STAGE(PG8_SB(0, 1), b2 + hstep, voffB);
            PG8_WAIT_V(6); PG8_BAR; PG8_MMA(1, 1, At, B1); PG8_BAR;
            PG8_LDB(B0, 1, 0); PG8_SCHED; PG8_LDA(At, 1, 0); PG8_STAGE(PG8_SA(0, 1), a2 + hstep, voffA);
            PG8_WAIT_L(8); PG8_BAR; PG8_WAIT_L(0); PG8_MMA(0, 0, At, B0); PG8_BAR; PG8_SCHED;
            PG8_LDB(B1, 1, 1); PG8_STAGE(PG8_SB(1, 0), b3, voffB);
            PG8_BAR; PG8_WAIT_L(0); PG8_MMA(0, 1, At, B1); PG8_BAR;
            PG8_LDA(At, 1, 1); PG8_STAGE(PG8_SA(1, 0), a3, voffA);
            PG8_BAR; PG8_WAIT_L(0); PG8_MMA(1, 0, At, B0); PG8_BAR; PG8_SCHED;
            PG8_STAGE(PG8_SB(1, 1), b3 + hstep, voffB);
            PG8_WAIT_V(6); PG8_BAR; PG8_MMA(1, 1, At, B1); PG8_BAR;
            }
        }
        if constexpr (ALIGN_EPI) { if (wr == 0) PG8_BAR; }
        if constexpr (!Epi::AFTER_DRAIN) { E(acc, cur, wr, wc, fr, fq); S.done(cur); }
        if (!has_next) break;
#pragma unroll
        for (int a = 0; a < 2; ++a)
#pragma unroll
            for (int b = 0; b < 2; ++b)
#pragma unroll
                for (int m = 0; m < 4; ++m)
#pragma unroll
                    for (int n = 0; n < 2; ++n) acc[a][b][m][n] = (f32x4){0.f, 0.f, 0.f, 0.f};
        cur = nxt; cA = nA; cB = nB; ++ui;
        if constexpr (ALIGN_EPI) { if (wr == 1) PG8_BAR; }
    }
    PG8_WAIT_V(0);
    if constexpr (!ALIGN_EPI) { if (wr == 0) PG8_BAR; }
    PG8_BAR;
    if constexpr (Epi::AFTER_DRAIN) { E.fused(acc, cur, wr, wc, fr, fq, lds, wid, lane); S.done(cur); }
#undef PG8_SA
#undef PG8_SB
#undef PG8_STAGE
#undef PG8_LDA
#undef PG8_LDB
#undef PG8_MMA
#undef PG8_WAIT_V
#undef PG8_WAIT_L
#undef PG8_BAR
#undef PG8_SCHED
}
}
#define LAS __attribute__((address_space(3)))
typedef unsigned short bf16;
typedef float f32x4 __attribute__((ext_vector_type(4)));
typedef unsigned u32x4 __attribute__((ext_vector_type(4)));
typedef unsigned u32x2 __attribute__((ext_vector_type(2)));
typedef short bf16x8 __attribute__((ext_vector_type(8)));
typedef short s16x4 __attribute__((ext_vector_type(4)));
#define LDS_WAIT() asm volatile("s_waitcnt lgkmcnt(0)" ::: "memory")

constexpr int D = 1024, FF = 2816, SEQ = 8192, MP = 16384, NSMP = 128, MR = 16512, MPAD = 16640;
constexpr int NWAVES = 8, NTHREADS = 512, LDS_BYTES = 147456;
#ifndef N_LAUNCH_PER_PHASE
#define N_LAUNCH_PER_PHASE 0
#endif
enum { I_XP = 0, I_XS, I_SCONV, I_CK, I_CV, I_GF1, I_W1G, I_W1U, I_W1D, I_GMIX, I_GF2, I_W2G, I_W2U, I_W2D, I_WINA, I_CONVW, I_WOUTA, I_GKV, I_WKV, I_GKN, I_WQ, I_GQN, I_SINKS, I_WO, N_IN };
constexpr size_t O_YP = 0, O_YS = 16777216, O_CONVP = 16908288, O_KP = 16916480, O_VP = 16982016, O_CONVS = 17047552, O_KS = 17571840, O_VS = 21766144, O_END = 25960448;
constexpr size_t MiB = 1u << 20;
constexpr size_t WS_SSQ = 0;
constexpr size_t SZ_WGU = (size_t)2 * FF * D * 2, SZ_WD = (size_t)D * FF * 2;
constexpr size_t WS_WGU = 1 * MiB;
constexpr size_t WS_WD = WS_WGU + 8 * SZ_WGU;
constexpr size_t WS_WIN = WS_WD + 8 * SZ_WD;
constexpr size_t WS_WOUT = WS_WIN + 2 * (size_t)3 * D * D * 2;
constexpr size_t WS_WKV = WS_WOUT + 2 * (size_t)D * D * 2;
constexpr size_t WS_WQ = WS_WKV + (size_t)512 * D * 2;
constexpr size_t WS_WO = WS_WQ + 2 * (size_t)D * D * 2;
constexpr size_t WS_XB = WS_WO + 2 * (size_t)D * D * 2;
constexpr size_t SZ_ACT = (size_t)MPAD * D * 2;
constexpr size_t WS_H = WS_XB + SZ_ACT;
constexpr size_t WS_KB = WS_H + (size_t)MPAD * FF * 2;
constexpr size_t WS_VT = WS_KB + (size_t)MP * 256 * 2;
constexpr size_t WS_END = WS_VT + (size_t)MP * 256 * 2;
static_assert(2 * SZ_ACT <= (size_t)MPAD * FF * 2, "overlays fit in H");

struct Args { const float* in[N_IN]; float* out; unsigned char* ws; int ph_lo, ph_hi; };
typedef const __attribute__((address_space(4))) Args* ArgsP;

__device__ __forceinline__ unsigned f2bf(float f) { unsigned u = __builtin_bit_cast(unsigned, f); return (u + 0x7fffu + ((u >> 16) & 1u)) >> 16; }
__device__ __forceinline__ unsigned pk2(float lo, float hi) { return f2bf(lo) | (f2bf(hi) << 16); }
__device__ __forceinline__ float bf2f(unsigned short b) { return __builtin_bit_cast(float, (unsigned)b << 16); }
__device__ __forceinline__ float bflo(unsigned w) { return __builtin_bit_cast(float, w << 16); }
__device__ __forceinline__ float bfhi(unsigned w) { return __builtin_bit_cast(float, w & 0xffff0000u); }
__device__ __forceinline__ float wave_sum(float v) {
#pragma unroll
    for (int o = 1; o < 64; o <<= 1) v += __shfl_xor(v, o);
    return v;
}
__device__ __forceinline__ float wave_max(float v) {
#pragma unroll
    for (int o = 1; o < 64; o <<= 1) v = fmaxf(v, __shfl_xor(v, o));
    return v;
}

__device__ __forceinline__ int rowmap(int mode, int n) {
    if (mode == 0) return n;
    if (mode == 1) return ((n >> 7) << 8) + (n & 127);
    if (mode == 2) return ((n >> 7) << 8) + 128 + (n & 127);
    if (mode == 3) {
        if (n < 1024) return 2048 + n;
        const int j = (n - 1024) & 1023; return ((j >> 7) << 8) + ((n >= 2048) ? 128 : 0) + (j & 127);
    }
    return (n & ~255) + (((n & 63) >> 5) << 7) + (((n >> 6) & 3) << 5) + (n & 31);
}
struct Job { const float* src; bf16* dst; const float* g; int K, N, mode; };
__device__ __forceinline__ Job get_job(ArgsP a, int j) {
    Job J; unsigned char* ws = a->ws;
    if (j < 24) {
        const int l = j / 6, r = j % 6, f = r / 3, t = r % 3;
        if (t < 2) { J.src = a->in[(f ? I_W2G : I_W1G) + t] + (size_t)l * D * FF; J.K = D; J.N = FF; J.dst = (bf16*)(ws + WS_WGU + (size_t)(2 * l + f) * SZ_WGU);
            J.g = a->in[f ? I_GF2 : I_GF1] + l * D; J.mode = 1 + t; }
        else { J.src = a->in[f ? I_W2D : I_W1D] + (size_t)l * FF * D; J.K = FF; J.N = D; J.dst = (bf16*)(ws + WS_WD + (size_t)(2 * l + f) * SZ_WD); J.g = nullptr; J.mode = 0; }
    } else if (j < 28) {
        const int i = (j - 24) >> 1, t = (j - 24) & 1;
        if (t == 0) { J.src = a->in[I_WINA] + (size_t)i * D * 3 * D; J.K = D; J.N = 3 * D; J.dst = (bf16*)(ws + WS_WIN + (size_t)i * 3 * D * D * 2); J.g = a->in[I_GMIX] + i * D; J.mode = 3; }
        else { J.src = a->in[I_WOUTA] + (size_t)i * D * D; J.K = D; J.N = D; J.dst = (bf16*)(ws + WS_WOUT + (size_t)i * D * D * 2); J.g = nullptr; J.mode = 0; }
    } else if (j == 28) {
        J.src = a->in[I_WKV]; J.K = D; J.N = 512; J.dst = (bf16*)(ws + WS_WKV); J.g = a->in[I_GKV]; J.mode = 4;
    } else {
        const int i = (j - 29) >> 1, t = (j - 29) & 1;
        if (t == 0) { J.src = a->in[I_WQ] + (size_t)i * D * D; J.K = D; J.N = D; J.dst = (bf16*)(ws + WS_WQ + (size_t)i * D * D * 2); J.g = a->in[I_GMIX] + (2 + i) * D; J.mode = 4; }
        else { J.src = a->in[I_WO] + (size_t)i * D * D; J.K = D; J.N = D; J.dst = (bf16*)(ws + WS_WO + (size_t)i * D * D * 2); J.g = nullptr; J.mode = 0; }
    }
    return J;
}
constexpr int NJOBS = 33;
__device__ __forceinline__ void transpose_item(const Job& J, int item, int lane) {
    const int nn = J.N >> 6, kb = item / nn, nb = item - kb * nn, k0 = kb * 32, n = nb * 64 + lane;
    const float* src = J.src + (size_t)k0 * J.N + n;
    float w[32];
#pragma unroll
    for (int j = 0; j < 32; ++j) w[j] = __builtin_nontemporal_load(src + (size_t)j * J.N);
    if (J.g) {
#pragma unroll
        for (int j = 0; j < 32; ++j) w[j] *= J.g[k0 + j];
    }
    bf16* dst = J.dst + (size_t)rowmap(J.mode, n) * J.K + k0;
#pragma unroll
    for (int c = 0; c < 4; ++c) { u32x4 o; o.x = pk2(w[8 * c], w[8 * c + 1]); o.y = pk2(w[8 * c + 2], w[8 * c + 3]); o.z = pk2(w[8 * c + 4], w[8 * c + 5]); o.w = pk2(w[8 * c + 6], w[8 * c + 7]);
        *(u32x4*)(dst + 8 * c) = o; }
}
__device__ __forceinline__ void prologue(ArgsP a, LAS unsigned char* lds, int gw, int ngw, int lane, int wave) {
    int base = 0;
    for (int j = 0; j < NJOBS; ++j) {
        const Job J = get_job(a, j); const int nitems = (J.K / 32) * (J.N / 64);
        int first = gw - (base % ngw); if (first < 0) first += ngw;
        for (int it = first; it < nitems; it += ngw) transpose_item(J, it, lane);
        base += nitems;
    }
    float* X = a->out; bf16* XB = (bf16*)(a->ws + WS_XB); float* ssq = (float*)(a->ws + WS_SSQ);
    for (int m = gw; m < MPAD; m += ngw) {
        u32x2* o8 = (u32x2*)(XB + (size_t)m * D) + lane;
        if (m < MR) {
            const float* src = (m < MP) ? a->in[I_XP] + (size_t)m * D : a->in[I_XS] + (size_t)(m - MP) * D;
            const f32x4* xr = (const f32x4*)src + lane; f32x4* xo = (f32x4*)(X + (size_t)m * D) + lane; float s = 0.f;
#pragma unroll
            for (int j = 0; j < 4; ++j) { const f32x4 v = xr[64 * j]; xo[64 * j] = v; s += (v[0] * v[0] + v[1] * v[1]) + (v[2] * v[2] + v[3] * v[3]);
                u32x2 w; w.x = pk2(v[0], v[1]); w.y = pk2(v[2], v[3]); o8[64 * j] = w; }
            s = wave_sum(s); if (lane == 0) ssq[m] = s;
        } else {
#pragma unroll
            for (int j = 0; j < 4; ++j) o8[64 * j] = (u32x2){0u, 0u};
            if (lane == 0) ssq[m] = 0.f;
        }
    }
    const int gt = gw * 64 + lane, ngt = ngw * 64;
    for (int i = gt; i < 12 * MPAD; i += ngt) ssq[MPAD + i] = 0.f;
    for (int i = gt; i < 2 * NSMP * 127 * 64; i += ngt) {
        const int which = i / (NSMP * 127 * 64), r = i % (NSMP * 127 * 64), b = r / (127 * 64), q = r % (127 * 64), jrow = q >> 6, c4 = q & 63;
        const f32x4 v = *((const f32x4*)(a->in[which ? I_CV : I_CK] + ((size_t)b * 128 + jrow + 1) * 256) + c4);
        *((f32x4*)(a->out + (which ? O_VS : O_KS) + ((size_t)b * 128 + jrow) * 256) + c4) = v;
    }
}

__device__ __forceinline__ void unpack8(const u32x4 w, float (&f)[8]) { f[0] = bflo(w.x); f[1] = bfhi(w.x); f[2] = bflo(w.y); f[3] = bfhi(w.y); f[4] = bflo(w.z); f[5] = bfhi(w.z); f[6] = bflo(w.w); f[7] = bfhi(w.w); }
__device__ __forceinline__ void conv_phase(ArgsP a, int layer, int gt, int ngt) {
    const bf16* CU = (const bf16*)(a->ws + WS_H); bf16* BZ = (bf16*)(a->ws + WS_H + SZ_ACT);
    const float* cw = a->in[I_CONVW] + (size_t)layer * 3 * D; const float* st = a->in[I_SCONV] + (size_t)layer * NSMP * 2 * D;
    float* convp = a->out + O_CONVP + (size_t)layer * 2 * 2 * D; float* convs = a->out + O_CONVS + (size_t)layer * NSMP * 2 * D;
    for (int idx = gt; idx < MR * 128; idx += ngt) {
        const int row = idx >> 7, c8 = (idx & 127) * 8;
        float b[8], c2[8], c1[8], c0[8];
        unpack8(*(const u32x4*)(BZ + (size_t)row * D + c8), b); unpack8(*(const u32x4*)(CU + (size_t)row * D + c8), c2);
        if (row < MP) {
            const int t = row & 8191;
            if (t >= 1) unpack8(*(const u32x4*)(CU + (size_t)(row - 1) * D + c8), c1); else { for (int e = 0; e < 8; ++e) c1[e] = 0.f; }
            if (t >= 2) unpack8(*(const u32x4*)(CU + (size_t)(row - 2) * D + c8), c0); else { for (int e = 0; e < 8; ++e) c0[e] = 0.f; }
            if (t >= 8190) { float* o = convp + ((size_t)(row >> 13) * 2 + (t - 8190)) * D + c8; *(f32x4*)o = (f32x4){c2[0], c2[1], c2[2], c2[3]}; *(f32x4*)(o + 4) = (f32x4){c2[4], c2[5], c2[6], c2[7]}; }
        } else {
            const int bs = row - MP; const float* s0 = st + ((size_t)bs * 2) * D + c8;
            const f32x4 a0 = *(const f32x4*)s0, a1 = *(const f32x4*)(s0 + 4), b0 = *(const f32x4*)(s0 + D), b1 = *(const f32x4*)(s0 + D + 4);
#pragma unroll
            for (int e = 0; e < 4; ++e) { c0[e] = a0[e]; c0[4 + e] = a1[e]; c1[e] = b0[e]; c1[4 + e] = b1[e]; }
            float* o = convs + ((size_t)bs * 2) * D + c8;
            *(f32x4*)o = b0; *(f32x4*)(o + 4) = b1; *(f32x4*)(o + D) = (f32x4){c2[0], c2[1], c2[2], c2[3]}; *(f32x4*)(o + D + 4) = (f32x4){c2[4], c2[5], c2[6], c2[7]};
        }
        const f32x4 w0a = *(const f32x4*)(cw + c8), w0b = *(const f32x4*)(cw + c8 + 4), w1a = *(const f32x4*)(cw + D + c8), w1b = *(const f32x4*)(cw + D + c8 + 4), w2a = *(const f32x4*)(cw + 2 * D + c8), w2b = *(const f32x4*)(cw + 2 * D + c8 + 4);
        float z[8];
#pragma unroll
        for (int e = 0; e < 4; ++e) { z[e] = b[e] * (w0a[e] * c0[e] + w1a[e] * c1[e] + w2a[e] * c2[e]); z[4 + e] = b[4 + e] * (w0b[e] * c0[4 + e] + w1b[e] * c1[4 + e] + w2b[e] * c2[4 + e]); }
        u32x4 w; w.x = pk2(z[0], z[1]); w.y = pk2(z[2], z[3]); w.z = pk2(z[4], z[5]); w.w = pk2(z[6], z[7]);
        *(u32x4*)(BZ + (size_t)row * D + c8) = w;
    }
}

constexpr int KROW = 144, VROW = 560, KL_BYTES = 272 * KROW, VT_OFF = 40960, VT_BYTES = 64 * VROW, SMP_OFF = 81920;
static_assert(KL_BYTES <= VT_OFF && VT_OFF + VT_BYTES <= SMP_OFF, "attention LDS map");
__device__ __forceinline__ void attn_phase(ArgsP a, int j, LAS unsigned char* lds, int tid, int lane, int wave, int bid, int G) {
    const bf16* Qb = (const bf16*)(a->ws + WS_H); bf16* Ob = (bf16*)(a->ws + WS_H + SZ_ACT);
    const bf16* Kb = (const bf16*)(a->ws + WS_KB); const bf16* Vt = (const bf16*)(a->ws + WS_VT);
    const float* sinks = a->in[I_SINKS] + j * 16;
    const int fr = lane & 15, fq = lane >> 4;
    for (int unit = bid; unit < 512; unit += G) {
        const int b = unit >> 8, kvh = (unit >> 6) & 3, qblk = unit & 63, t0 = qblk * 128;
        __syncthreads();
        for (int c = tid; c < 272 * 8; c += NTHREADS) { const int row = c >> 3, ch = c & 7, t = t0 - 128 + row;
            u32x4 v = (u32x4){0u, 0u, 0u, 0u}; if (row < 256 && t >= 0) v = *(const u32x4*)(Kb + ((size_t)b * SEQ + t) * 256 + kvh * 64 + ch * 8);
            *(LAS u32x4*)(lds + row * KROW + ch * 16) = v; }
        for (int c = tid; c < 64 * 34; c += NTHREADS) { const int d = c / 34, ch = c % 34, t = t0 - 128 + ch * 8;
            u32x4 v = (u32x4){0u, 0u, 0u, 0u}; if (ch < 32 && t >= 0) v = *(const u32x4*)(Vt + ((size_t)(b * 4 + kvh) * 64 + d) * SEQ + t);
            *(LAS u32x4*)(lds + VT_OFF + d * VROW + ch * 16) = v; }
        __syncthreads();
        const int head = kvh * 4 + (wave >> 1); const float sink = sinks[head];
        for (int qt = 0; qt < 4; ++qt) {
            const int q0 = (wave & 1) * 64 + qt * 16, cb = q0 >> 4;
            const size_t grow = (size_t)b * SEQ + t0 + q0 + fr;
            const bf16x8 qf0 = *(const bf16x8*)(Qb + grow * D + head * 64 + fq * 8), qf1 = *(const bf16x8*)(Qb + grow * D + head * 64 + 32 + fq * 8);
            f32x4 s[10];
#pragma unroll
            for (int c = 0; c < 10; ++c) {
                const LAS unsigned char* kp = lds + (16 * (cb + c) + fr) * KROW + fq * 16;
                f32x4 acc = (f32x4){0.f, 0.f, 0.f, 0.f};
                acc = __builtin_amdgcn_mfma_f32_16x16x32_bf16(*(const LAS bf16x8*)kp, qf0, acc, 0, 0, 0);
                acc = __builtin_amdgcn_mfma_f32_16x16x32_bf16(*(const LAS bf16x8*)(kp + 64), qf1, acc, 0, 0, 0);
                s[c] = acc;
            }
            const int qi = q0 + fr; float mx = -INFINITY;
#pragma unroll
            for (int c = 0; c < 10; ++c)
#pragma unroll
                for (int i = 0; i < 4; ++i) { const int kj = 16 * (cb + c) + 4 * fq + i; const bool ok = (kj >= qi + 1) && (kj <= qi + 128) && (qblk > 0 || kj >= 128);
                    s[c][i] = ok ? s[c][i] : -INFINITY; mx = fmaxf(mx, s[c][i]); }
            mx = fmaxf(mx, __shfl_xor(mx, 16)); mx = fmaxf(mx, __shfl_xor(mx, 32)); mx = fmaxf(mx, sink);
            float sum = 0.f;
#pragma unroll
            for (int c = 0; c < 10; ++c)
#pragma unroll
                for (int i = 0; i < 4; ++i) { const float p = __expf(s[c][i] - mx); s[c][i] = p; sum += p; }
            sum += __shfl_xor(sum, 16); sum += __shfl_xor(sum, 32);
            const float inv = 1.0f / (sum + __expf(sink - mx));
            bf16x8 pb[5];
#pragma unroll
            for (int pp = 0; pp < 5; ++pp) { u32x4 w; w.x = pk2(s[2 * pp][0], s[2 * pp][1]); w.y = pk2(s[2 * pp][2], s[2 * pp][3]); w.z = pk2(s[2 * pp + 1][0], s[2 * pp + 1][1]); w.w = pk2(s[2 * pp + 1][2], s[2 * pp + 1][3]);
                pb[pp] = __builtin_bit_cast(bf16x8, w); }
#pragma unroll
            for (int dt = 0; dt < 4; ++dt) {
                f32x4 o = (f32x4){0.f, 0.f, 0.f, 0.f};
#pragma unroll
                for (int pp = 0; pp < 5; ++pp) {
                    const LAS unsigned char* vp = lds + VT_OFF + (16 * dt + fr) * VROW + (16 * (cb + 2 * pp) + 4 * fq) * 2;
                    const u32x2 lo = *(const LAS u32x2*)vp, hi = *(const LAS u32x2*)(vp + 32);
                    const u32x4 av = (u32x4){lo.x, lo.y, hi.x, hi.y};
                    o = __builtin_amdgcn_mfma_f32_16x16x32_bf16(__builtin_bit_cast(bf16x8, av), pb[pp], o, 0, 0, 0);
                }
                o = o * inv; u32x2 w; w.x = pk2(o[0], o[1]); w.y = pk2(o[2], o[3]);
                *(u32x2*)(Ob + grow * D + head * 64 + 16 * dt + 4 * fq) = w;
            }
        }
    }
    __syncthreads();
    LAS float* wq = (LAS float*)(lds + SMP_OFF + wave * 1024); LAS float* wsc = wq + 64;
    for (int task = bid * NWAVES + wave; task < NSMP * 16; task += G * NWAVES) {
        const int b = task >> 4, h = task & 15, kvh = h >> 2; const float sink = sinks[h];
        const size_t qoff = (size_t)(MP + b) * D + h * 64;
        wq[lane] = bf2f(Qb[qoff + lane]);
        LDS_WAIT();
        const int sub = lane >> 4, dq = lane & 15;
        const f32x4 q4 = *(const LAS f32x4*)(wq + 4 * dq);
        const float* ks = a->out + O_KS + (size_t)b * 128 * 256 + kvh * 64; const float* vs = a->out + O_VS + (size_t)b * 128 * 256 + kvh * 64;
        for (int it = 0; it < 32; ++it) { const int key = it * 4 + sub; const f32x4 k4 = *(const f32x4*)(ks + (size_t)key * 256 + 4 * dq);
            float p = (q4[0] * k4[0] + q4[1] * k4[1]) + (q4[2] * k4[2] + q4[3] * k4[3]);
            p += __shfl_xor(p, 1); p += __shfl_xor(p, 2); p += __shfl_xor(p, 4); p += __shfl_xor(p, 8);
            if (dq == 0) wsc[key] = p; }
        LDS_WAIT();
        const float s0 = wsc[lane], s1 = wsc[lane + 64];
        const float mx = fmaxf(wave_max(fmaxf(s0, s1)), sink);
        const float p0 = __expf(s0 - mx), p1 = __expf(s1 - mx);
        const float inv = 1.0f / (wave_sum(p0 + p1) + __expf(sink - mx));
        LDS_WAIT();
        wsc[lane] = p0; wsc[lane + 64] = p1;
        LDS_WAIT();
        float o = 0.f;
#pragma unroll 8
        for (int key = 0; key < 128; ++key) o += wsc[key] * vs[(size_t)key * 256 + lane];
        Ob[qoff + lane] = (bf16)f2bf(o * inv);
        LDS_WAIT();
    }
}
#define RLX_AGENT __ATOMIC_RELAXED, __HIP_MEMORY_SCOPE_AGENT
constexpr size_t WS_BAR = 896 * 1024;
constexpr int MISC_OFF = 131072 + 64;
#define XB_TMO      128
#define XB_XCNT(j)  (256  + 64 * (j))
#define XB_XSUB(j)  (1280 + 64 * (j))
#define XB_XGEN(j)  (2304 + 64 * (j))
#define XB_TOP      3328
#define XB_TOPGEN   3392
#define XCD_BAR_WORDS 3456
#define XB_SPIN_CAP (1u << 18)

__device__ __forceinline__ unsigned xb_ld(unsigned* p)              { return __hip_atomic_load(p, __ATOMIC_RELAXED, __HIP_MEMORY_SCOPE_AGENT); }
__device__ __forceinline__ unsigned xb_add(unsigned* p, unsigned v) { return __hip_atomic_fetch_add(p, v, __ATOMIC_RELAXED, __HIP_MEMORY_SCOPE_AGENT); }
__device__ __forceinline__ unsigned xb_xcc_id() { return (unsigned)__builtin_amdgcn_s_getreg((3 << 11) | 20) & 0xFu; }
#define XB_SPIN(cond, bar) do { unsigned _sp = 0; while (cond) { __builtin_amdgcn_s_sleep(1); \
    if ((++_sp & 255u) == 0u) { if (xb_ld(&(bar)[XB_TMO])) break; if (_sp > XB_SPIN_CAP) { atomicAdd(&(bar)[XB_TMO], 1u); break; } } } } while (0)

struct XcdBarrier {
    unsigned* bar; unsigned x;
    volatile LAS unsigned* st;
};

__device__ __forceinline__ XcdBarrier xcd_barrier_post(unsigned* bar, volatile LAS unsigned* st) {
    XcdBarrier b; b.bar = bar; b.x = xb_xcc_id(); b.st = st;
    if (threadIdx.x == 0) (void)xb_add(&bar[XB_XCNT(b.x)], 1u);
    return b;
}
__device__ __forceinline__ void xcd_barrier_complete(unsigned* bar, unsigned x, unsigned& nloc, unsigned& nx) {
    const unsigned G = gridDim.x * gridDim.y * gridDim.z;
    unsigned sum, cnt, mine, sp = 0u;
    for (;;) {
        sum = 0u; cnt = 0u; mine = 0u;
#pragma unroll
        for (unsigned j = 0; j < 16; ++j) { const unsigned c = xb_ld(&bar[XB_XCNT(j)]); sum += c; cnt += (c > 0u) ? 1u : 0u; mine = (j == x) ? c : mine; }
        if (sum == G) break;
        __builtin_amdgcn_s_sleep(1);
        if ((++sp & 255u) == 0u) { if (xb_ld(&bar[XB_TMO])) break; if (sp > XB_SPIN_CAP) { atomicAdd(&bar[XB_TMO], 1u); break; } }
    }
    nloc = mine > 0u ? mine : 1u; nx = cnt > 0u ? cnt : 1u;
}

__device__ __forceinline__ void xcd_barrier(const XcdBarrier& b) {
    asm volatile("s_waitcnt vmcnt(0)" ::: "memory");
    __syncthreads();
    if (threadIdx.x == 0) {
        unsigned* bar = b.bar;
        __builtin_amdgcn_s_waitcnt(0);
        unsigned nloc = b.st[0], nx = b.st[1];
        if (nloc == 0u) { xcd_barrier_complete(bar, b.x, nloc, nx); b.st[0] = nloc; b.st[1] = nx; }
        const unsigned old = xb_add(&bar[XB_XSUB(b.x)], 1u);
        const unsigned gen = old / nloc;
        if (old + 1u == (gen + 1u) * nloc) {
            __builtin_amdgcn_fence(__ATOMIC_RELEASE, "agent");
            asm volatile("s_waitcnt vmcnt(0)" ::: "memory");
            const unsigned og = xb_add(&bar[XB_TOP], 1u);
            const unsigned tg = og / nx;
            if (og + 1u == (tg + 1u) * nx) xb_add(&bar[XB_TOPGEN], 1u);
            else XB_SPIN(xb_ld(&bar[XB_TOPGEN]) == tg, bar);
            __builtin_amdgcn_fence(__ATOMIC_ACQUIRE, "agent");
            xb_add(&bar[XB_XGEN(b.x)], 1u);
            asm volatile("s_waitcnt vmcnt(0)" ::: "memory");
        } else {
            XB_SPIN(xb_ld(&bar[XB_XGEN(b.x)]) == gen, bar);
            __builtin_amdgcn_fence(__ATOMIC_ACQUIRE, "agent");
            asm volatile("s_waitcnt vmcnt(0)" ::: "memory");
        }
    }
    __syncthreads();
}

#ifndef KMASK
#define KMASK 511
#endif
#ifndef DUPMASK
#define DUPMASK 0
#endif
constexpr int NSTEPS = 30;
template <class Epi>
__device__ __forceinline__ void run_gemm(int tid, int bid, int G, LAS unsigned char* lds, const bf16* A, const bf16* Bt, int M, int N, int K, const Epi& E) {
    pg8::Gemm g{A, Bt, M, N, K}; pg8::StaticOrder S; S.init(M, N, G, bid);
    pg8::gemm_phase<Epi, pg8::StaticOrder, true, true>(tid, lds, g, S, E);
}
template <class Epi>
__device__ __forceinline__ void sample_gemm(LAS unsigned char* lds, const bf16* A, const bf16* Bt, int N, int K, const Epi& E, int wg_first, int wg_count, int bid, int wave, int lane) {
    if (bid < wg_first) return;
    const int fr = lane & 15, fq = lane >> 4, ntasks = (N >> 8) * 32, kw = K >> 3;
    LAS float* part = (LAS float*)lds;
    for (int task = bid - wg_first; task < ntasks; task += wg_count) {
        const int rg = task & 7, wc = (task >> 3) & 3, pn = task >> 5;
        const bf16* ap = A + (size_t)(MP + 16 * rg + fr) * K + wave * kw + 8 * fq;
        const bf16* bp[2][2];
#pragma unroll
        for (int bj = 0; bj < 2; ++bj)
#pragma unroll
            for (int n = 0; n < 2; ++n) { const int wrow = pn * 256 + bj * 128 + wc * 32 + (Epi::PERM ? (8 * (fr >> 2) + 4 * n + (fr & 3)) : (16 * n + fr));
                bp[bj][n] = Bt + (size_t)wrow * K + wave * kw + 8 * fq; }
        f32x4 acc[2][2];
#pragma unroll
        for (int bj = 0; bj < 2; ++bj)
#pragma unroll
            for (int n = 0; n < 2; ++n) acc[bj][n] = (f32x4){0.f, 0.f, 0.f, 0.f};
#pragma unroll 4
        for (int k = 0; k < kw; k += 32) {
            const bf16x8 av = *(const bf16x8*)(ap + k);
#pragma unroll
            for (int bj = 0; bj < 2; ++bj)
#pragma unroll
                for (int n = 0; n < 2; ++n) acc[bj][n] = __builtin_amdgcn_mfma_f32_16x16x32_bf16(*(const bf16x8*)(bp[bj][n] + k), av, acc[bj][n], 0, 0, 0);
        }
#pragma unroll
        for (int bj = 0; bj < 2; ++bj)
#pragma unroll
            for (int n = 0; n < 2; ++n)
#pragma unroll
                for (int e = 0; e < 4; ++e) part[(wave * 16 + bj * 8 + n * 4 + e) * 64 + lane] = acc[bj][n][e];
        __syncthreads();
        if (wave == 0) {
            f32x4 v[2][2];
#pragma unroll
            for (int bj = 0; bj < 2; ++bj)
#pragma unroll
                for (int n = 0; n < 2; ++n)
#pragma unroll
                    for (int e = 0; e < 4; ++e) { float sacc = 0.f;
#pragma unroll
                        for (int w = 0; w < 8; ++w) sacc += part[(w * 16 + bj * 8 + n * 4 + e) * 64 + lane];
                        v[bj][n][e] = sacc; }
            E.row(MP + 16 * rg + fr, v, pn, wc, fr, fq);
        }
        __syncthreads();
    }
}
__global__ void __launch_bounds__(NTHREADS, 2) yoco_fwd(Args a) {
    extern __shared__ __attribute__((aligned(16))) unsigned char lds_raw[];
    LAS unsigned char* lds = (LAS unsigned char*)lds_raw;
    cg::grid_group grid = cg::this_grid();
    const int ph_hi = a.ph_hi;
    if (threadIdx.x < 64) ((volatile LAS unsigned*)(lds + 131072))[threadIdx.x] = 0u;
    __syncthreads();
    XcdBarrier bar; bar.bar = (unsigned*)(a.ws + WS_BAR); bar.x = 0; bar.st = (volatile LAS unsigned*)(lds + MISC_OFF);
    if (a.ph_lo > 0) bar = xcd_barrier_post((unsigned*)(a.ws + WS_BAR), (volatile LAS unsigned*)(lds + MISC_OFF));
    int rep = 0; bool posted = a.ph_lo > 0;
    for (int s = a.ph_lo; s < ph_hi; ) {
        ArgsP ap = (ArgsP)__builtin_amdgcn_kernarg_segment_ptr(); asm volatile("" : "+s"(ap));
        int tid = threadIdx.x; asm volatile("" : "+v"(tid));
        int bid = blockIdx.x, G = gridDim.x; asm volatile("" : "+s"(bid), "+s"(G));
        const int lane = tid & 63, wave = __builtin_amdgcn_readfirstlane(tid >> 6);
        const int gw = bid * NWAVES + wave, ngw = G * NWAVES, gt = bid * NTHREADS + tid, ngt = G * NTHREADS;
        unsigned char* ws = ap->ws;
        float* ssq = (float*)(ws + WS_SSQ); float* X = ap->out; bf16* XB = (bf16*)(ws + WS_XB); bf16* H = (bf16*)(ws + WS_H);
        bf16* CUQ = (bf16*)(ws + WS_H); bf16* BZO = (bf16*)(ws + WS_H + SZ_ACT);
        int kind, l = 0, f = 0;
        if (s == 0) kind = 0;
        else if (s == 15) kind = 9;
        else { const int r = (s < 15) ? s - 1 : s - 2; l = r / 7; const int jj = r % 7;
            if (jj == 0) { kind = 1; f = 0; } else if (jj == 1) { kind = 2; f = 0; } else if (jj == 5) { kind = 1; f = 1; } else if (jj == 6) { kind = 2; f = 1; }
            else kind = (l < 2 ? 3 : 6) + (jj - 2); }
        if (kind == 0 && rep == 0) { if (bid == 0) for (int i = tid; i < XCD_BAR_WORDS; i += NTHREADS) __hip_atomic_store((unsigned*)(ws + WS_BAR) + i, 0u, RLX_AGENT); }
        if (kind == 0 && (KMASK & 1)) prologue(ap, lds, gw, ngw, lane, wave);
        else if (kind == 1 && (KMASK & 2)) {
            pg8::EpiSwiGLU E{H, ssq + (size_t)(3 * l + 2 * f) * MPAD};
            const bf16* Bt = (const bf16*)(ws + WS_WGU + (size_t)(2 * l + f) * SZ_WGU);
            run_gemm(tid, bid, G, lds, XB, Bt, MP, 2 * FF, D, E);
            sample_gemm(lds, XB, Bt, 2 * FF, D, E, G / 2, G - G / 2, bid, wave, lane);
        } else if (kind == 2 && (KMASK & 4)) {
            pg8::EpiResid E{X, XB, ssq + (size_t)(3 * l + 2 * f + 1) * MPAD, 0.5f};
            const bf16* Bt = (const bf16*)(ws + WS_WD + (size_t)(2 * l + f) * SZ_WD);
            run_gemm(tid, bid, G, lds, H, Bt, MP, D, FF, E);
            sample_gemm(lds, H, Bt, D, FF, E, 0, G, bid, wave, lane);
        } else if (kind == 3 && (KMASK & 8)) {
            pg8::EpiInProj E{CUQ, BZO, ssq + (size_t)(3 * l + 1) * MPAD};
            const bf16* Bt = (const bf16*)(ws + WS_WIN + (size_t)l * 3 * D * D * 2);
            run_gemm(tid, bid, G, lds, XB, Bt, MP, 3 * D, D, E);
            sample_gemm(lds, XB, Bt, 3 * D, D, E, 0, G, bid, wave, lane);
        } else if (kind == 4 && (KMASK & 16)) conv_phase(ap, l, gt, ngt);
        else if ((kind == 5 || kind == 8) && (KMASK & 32)) {
            pg8::EpiResid E{X, XB, ssq + (size_t)(3 * l + 2) * MPAD, 1.0f};
            const bf16* Bt = (kind == 5) ? (const bf16*)(ws + WS_WOUT + (size_t)l * D * D * 2) : (const bf16*)(ws + WS_WO + (size_t)(l - 2) * D * D * 2);
            run_gemm(tid, bid, G, lds, BZO, Bt, MP, D, D, E);
            sample_gemm(lds, BZO, Bt, D, D, E, 0, G, bid, wave, lane);
        } else if (kind == 6 && (KMASK & 64)) {
            pg8::EpiQ E{CUQ, ssq + (size_t)(3 * l + 1) * MPAD, ap->in[I_GQN] + (l - 2) * 64};
            const bf16* Bt = (const bf16*)(ws + WS_WQ + (size_t)(l - 2) * D * D * 2);
            run_gemm(tid, bid, G, lds, XB, Bt, MP, D, D, E);
            sample_gemm(lds, XB, Bt, D, D, E, 0, G, bid, wave, lane);
        } else if (kind == 7 && (KMASK & 128)) attn_phase(ap, l - 2, lds, tid, lane, wave, bid, G);
        else if (kind == 9 && (KMASK & 256)) {
            pg8::EpiKV E{(bf16*)(ws + WS_KB), (bf16*)(ws + WS_VT), ssq + (size_t)6 * MPAD, ap->in[I_GKN], ap->out + O_KP, ap->out + O_VP, ap->out + O_KS, ap->out + O_VS};
            run_gemm(tid, bid, G, lds, XB, (const bf16*)(ws + WS_WKV), MP, 512, D, E);
            sample_gemm(lds, XB, (const bf16*)(ws + WS_WKV), 512, D, E, G / 2, G - G / 2, bid, wave, lane);
        }
        const bool again = ((DUPMASK >> kind) & 1) && rep == 0;
        if (again || s + 1 < ph_hi) {
            if (!posted) { grid.sync(); bar = xcd_barrier_post((unsigned*)(ws + WS_BAR), (volatile LAS unsigned*)(lds + MISC_OFF)); posted = true; }
            else xcd_barrier(bar);
        }
        if (again) rep = 1; else { rep = 0; ++s; }
    }
}

extern "C" void kernel_launch(void* const* d_in, const int* in_sizes, int n_in, void* d_out, int out_size, void* d_ws, size_t ws_size, hipStream_t stream) {
    static int grid = 0;
    if (grid == 0) {
        if (n_in != N_IN || (size_t)out_size != O_END || ws_size < WS_END) { fprintf(stderr, "kernel_launch: unexpected shapes: n_in %d out %d ws %zu (need %zu)\n", n_in, out_size, ws_size, (size_t)WS_END); grid = -1; return; }
        int dev = 0, cus = 0, per_cu = 0;
        hipGetDevice(&dev); hipDeviceGetAttribute(&cus, hipDeviceAttributeMultiprocessorCount, dev);
        if (hipFuncSetAttribute((const void*)yoco_fwd, hipFuncAttributeMaxDynamicSharedMemorySize, LDS_BYTES) != hipSuccess) { fprintf(stderr, "kernel_launch: hipFuncSetAttribute failed\n"); grid = -1; return; }
        if (hipOccupancyMaxActiveBlocksPerMultiprocessor(&per_cu, (const void*)yoco_fwd, NTHREADS, LDS_BYTES) != hipSuccess || per_cu < 1) { fprintf(stderr, "kernel_launch: occupancy query says %d\n", per_cu); per_cu = 1; }
        (void)hipGetLastError();
        grid = cus * 1;
    }
    if (grid < 0) return;
    Args a{};
    for (int i = 0; i < N_IN; ++i) a.in[i] = (const float*)d_in[i];
    a.out = (float*)d_out; a.ws = (unsigned char*)d_ws;
#if N_LAUNCH_PER_PHASE
    for (int s = 0; s < NSTEPS; ++s) { a.ph_lo = s; a.ph_hi = s + 1; hipLaunchKernelGGL(yoco_fwd, dim3(grid), dim3(NTHREADS), LDS_BYTES, stream, a); }
#else
    a.ph_lo = 0; a.ph_hi = NSTEPS;
    void* args[] = {&a};
    hipError_t e = hipLaunchCooperativeKernel((const void*)yoco_fwd, dim3(grid), dim3(NTHREADS), args, LDS_BYTES, stream);
    if (e != hipSuccess) fprintf(stderr, "kernel_launch: cooperative launch failed: %s (grid %d)\n", hipGetErrorString(e), grid);
#endif
}
```

```cpp
#include <hip/hip_runtime.h>
#include <hip/hip_cooperative_groups.h>
#include <cstdio>
#include <cstdint>
namespace cg = cooperative_groups;
#define N_LAUNCH_PER_PHASE 0
namespace pg8 {
#define PG8_LAS __attribute__((address_space(3)))
typedef unsigned short bf16_t;
typedef short bf16x8 __attribute__((ext_vector_type(8)));
typedef float f32x4 __attribute__((ext_vector_type(4)));
typedef unsigned u32x4 __attribute__((ext_vector_type(4)));
constexpr int BM = 256, BK = 64, HALF = 128, HTB = HALF * BK * 2  , STAGE_BYTES = 8 * HTB, NXCD = 8, WGM = 8;

__host__ __device__ __forceinline__ int lds_byte(int r, int c) { const int st = (r >> 4) * 2 + (c >> 5), rr = r & 15, cc = c & 31, ob = rr * 64 + cc * 2; return st * 1024 + (ob ^ (((ob >> 9) & 1) << 5)); }
__host__ __device__ __forceinline__ void stage_rc(int b, int& R, int& C) { const int st = b / 1024, sb = b % 1024, swz = sb ^ (((sb >> 9) & 1) << 5); R = (st >> 1) * 16 + swz / 64; C = (st & 1) * 32 + (swz % 64) / 2; }
__host__ __device__ __forceinline__ int perm32(int rho) { const int n = rho >> 4, i = rho & 15; return 8 * (i >> 2) + 4 * n + (i & 3); }

struct Unit { int pm, pn; };
struct Gemm { const bf16_t* A; const bf16_t* Bt; int M, N, K; };

struct StaticOrder {
    int nM, nN, nwg, G, c;
    __host__ __device__ void init(int M, int N, int G_, int c_) { nM = M / BM; nN = N / BM; nwg = nM * nN; G = G_; c = c_; }
    __host__ __device__ bool next(int i, Unit& u) const {
        const long L = (long)i * G + c; if (L >= nwg) return false;
        int wgid = (int)L; { const int q = nwg / NXCD, r = nwg % NXCD, xcd = wgid % NXCD, off = wgid / NXCD; wgid = (xcd < r ? xcd * (q + 1) : r * (q + 1) + (xcd - r) * q) + off; }
        const int nig = WGM * nN, gid = wgid / nig, fm = gid * WGM, gsz = (nM - fm) < WGM ? (nM - fm) : WGM;
        u.pm = fm + ((wgid % nig) % gsz); u.pn = (wgid % nig) / gsz; return true;
    }
    __device__ __forceinline__ void a_ready(const Unit&) const {}
    __device__ __forceinline__ void done(const Unit&) const {}
};

__device__ __forceinline__ unsigned cvt_pk_bf16(float lo, float hi) { unsigned r; asm volatile("v_cvt_pk_bf16_f32 %0, %1, %2" : "=v"(r) : "v"(lo), "v"(hi)); return r; }
struct PrefS { float s[8]; };
#define PG8_EPI_CALL(PREFB) typedef PrefS Pref; static constexpr bool PREF = PREFB; \
    __device__ __forceinline__ void prefetch(Pref& pf, const Unit& u, int wr, int fr) const { \
        if (ssq_ptr()) { _Pragma("unroll") for (int i = 0; i < 8; ++i) pf.s[i] = ssq_ptr()[u.pm * BM + wr * 64 + fr + (i >> 2) * HALF + (i & 3) * 16]; } } \
    __device__ __forceinline__ void operator()(const f32x4 (&acc)[2][2][4][2], const Unit& u, int wr, int wc, int fr, int fq, Pref& pf) const { \
        const int row0 = u.pm * BM + wr * 64 + fr; \
        if (!PREF) prefetch(pf, u, wr, fr); \
        _Pragma("unroll") for (int ai = 0; ai < 2; ++ai) _Pragma("unroll") for (int m = 0; m < 4; ++m) { \
            const f32x4 v[2][2] = {{acc[ai][0][m][0], acc[ai][0][m][1]}, {acc[ai][1][m][0], acc[ai][1][m][1]}}; \
            row(row0 + ai * HALF + m * 16, v, u.pn, wc, fr, fq, pf.s[ai * 4 + m]); } }
typedef unsigned u32x2 __attribute__((ext_vector_type(2)));
constexpr int ROWS_REAL = 16512, ROWS_PROMPT = 16384, DM = 1024, DFF = 2816;
__device__ __forceinline__ float rstd_from(float ssqv) { return __builtin_amdgcn_rsqf(ssqv * (1.0f / 1024.0f) + 1e-6f); }
__device__ __forceinline__ float silu_mul(float g, float u) { return g * __builtin_amdgcn_rcpf(1.0f + __expf(-g)) * u; }

struct EpiSwiGLU {
    static constexpr bool PERM = true, AFTER_DRAIN = false;
    bf16_t* H; const float* ssq;
    __device__ __forceinline__ void row(const int row, const f32x4 (&v)[2][2], int pn, int wc, int fr, int fq, float ssqv) const {
        const float r = rstd_from(ssqv);
        const f32x4 g0 = v[0][0] * r, g1 = v[0][1] * r, u0 = v[1][0] * r, u1 = v[1][1] * r;
        u32x4 w;
        w.x = cvt_pk_bf16(silu_mul(g0[0], u0[0]), silu_mul(g0[1], u0[1])); w.y = cvt_pk_bf16(silu_mul(g0[2], u0[2]), silu_mul(g0[3], u0[3]));
        w.z = cvt_pk_bf16(silu_mul(g1[0], u1[0]), silu_mul(g1[1], u1[1])); w.w = cvt_pk_bf16(silu_mul(g1[2], u1[2]), silu_mul(g1[3], u1[3]));
        *(u32x4*)(H + (size_t)row * DFF + pn * 128 + wc * 32 + 8 * fq) = w;
    }
    __device__ __forceinline__ const float* ssq_ptr() const { return ssq; }
    PG8_EPI_CALL(true)
};

struct EpiResid {
    static constexpr bool PERM = false, AFTER_DRAIN = false;
    float* X; bf16_t* XB; float* ssq_next; float scale;
    __device__ __forceinline__ void row(const int row, const f32x4 (&v)[2][2], int pn, int wc, int fr, int fq, float) const {
        const int col0 = pn * BM + wc * 32 + 4 * fq; float ss = 0.f;
#pragma unroll
        for (int bj = 0; bj < 2; ++bj)
#pragma unroll
            for (int n = 0; n < 2; ++n) {
                const size_t off = (size_t)row * DM + col0 + bj * HALF + n * 16;
                f32x4 x = *(const f32x4*)(X + off); x = x + v[bj][n] * scale; *(f32x4*)(X + off) = x;
                u32x2 w; w.x = cvt_pk_bf16(x[0], x[1]); w.y = cvt_pk_bf16(x[2], x[3]); *(u32x2*)(XB + off) = w;
                ss += (x[0] * x[0] + x[1] * x[1]) + (x[2] * x[2] + x[3] * x[3]);
            }
        ss += __shfl_xor(ss, 16); ss += __shfl_xor(ss, 32);
        if (fq == 0) __hip_atomic_fetch_add(ssq_next + row, ss, __ATOMIC_RELAXED, __HIP_MEMORY_SCOPE_AGENT);
    }
    __device__ __forceinline__ const float* ssq_ptr() const { return nullptr; }
    PG8_EPI_CALL(false)
};

struct EpiInProj {
    static constexpr bool PERM = true, AFTER_DRAIN = false;
    bf16_t* CU; bf16_t* BZ; const float* ssq;
    __device__ __forceinline__ void row(const int row, const f32x4 (&v)[2][2], int pn, int wc, int fr, int fq, float ssqv) const {
        const float r = rstd_from(ssqv);
        if (pn < 8) {
            const float r2 = r * r; const f32x4 p0 = v[0][0] * v[1][0] * r2, p1 = v[0][1] * v[1][1] * r2;
            u32x4 w; w.x = cvt_pk_bf16(p0[0], p0[1]); w.y = cvt_pk_bf16(p0[2], p0[3]); w.z = cvt_pk_bf16(p1[0], p1[1]); w.w = cvt_pk_bf16(p1[2], p1[3]);
            *(u32x4*)(CU + (size_t)row * DM + pn * 128 + wc * 32 + 8 * fq) = w;
        } else {
#pragma unroll
            for (int bj = 0; bj < 2; ++bj) {
                const f32x4 p0 = v[bj][0] * r, p1 = v[bj][1] * r;
                u32x4 w; w.x = cvt_pk_bf16(p0[0], p0[1]); w.y = cvt_pk_bf16(p0[2], p0[3]); w.z = cvt_pk_bf16(p1[0], p1[1]); w.w = cvt_pk_bf16(p1[2], p1[3]);
                *(u32x4*)(BZ + (size_t)row * DM + (pn - 8) * BM + bj * HALF + wc * 32 + 8 * fq) = w;
            }
        }
    }
    __device__ __forceinline__ const float* ssq_ptr() const { return ssq; }
    PG8_EPI_CALL(true)
};

__device__ __forceinline__ void head_norm_rope(f32x4 (&v)[2][2], const f32x4 (&g)[2][2], int pos, int fq) {
    float ss = 0.f;
#pragma unroll
    for (int bj = 0; bj < 2; ++bj)
#pragma unroll
        for (int n = 0; n < 2; ++n) ss += (v[bj][n][0] * v[bj][n][0] + v[bj][n][1] * v[bj][n][1]) + (v[bj][n][2] * v[bj][n][2] + v[bj][n][3] * v[bj][n][3]);
    ss += __shfl_xor(ss, 16); ss += __shfl_xor(ss, 32);
    const float hr = __builtin_amdgcn_rsqf(ss * (1.0f / 64.0f) + 1e-6f);
#pragma unroll
    for (int bj = 0; bj < 2; ++bj)
#pragma unroll
        for (int n = 0; n < 2; ++n) v[bj][n] = v[bj][n] * hr * g[bj][n];
    const f32x4 x = v[0][0]; f32x4 o;
    const bool lo = (fq & 1) == 0;
    const float f0 = lo ? 1.0f : 0.001414213562373095f, f1 = lo ? 0.19392274474868576f : 0.0002742481756762073f;
    const float f2 = lo ? 0.03760603093086393f : 5.318295896944988e-05f, f3 = lo ? 0.007292664737217109f : 1.031338537721246e-05f;
    const float fr4[4] = {f0, f1, f2, f3};
#pragma unroll
    for (int e = 0; e < 4; ++e) {
        const float partner = __shfl_xor(x[e], 32);
        const float ang = (float)pos * fr4[e];
        double rev = (double)ang * 0.15915494309189535; rev -= __builtin_floor(rev);
        const float rv = (float)rev; const float s = __builtin_amdgcn_sinf(rv), c = __builtin_amdgcn_cosf(rv);
        o[e] = (fq < 2) ? (x[e] * c - partner * s) : (x[e] * c + partner * s);
    }
    v[0][0] = o;
}
__device__ __forceinline__ int row_pos(int row) { return row < ROWS_PROMPT ? (row & 8191) : 8192; }

struct EpiQ {
    static constexpr bool PERM = false, AFTER_DRAIN = false;
    bf16_t* Qb; const float* ssq; const float* gq;
    __device__ __forceinline__ void row(const int row, const f32x4 (&vin)[2][2], int pn, int wc, int fr, int fq, float ssqv) const {
        const int colh = pn * BM + 64 * wc + 4 * fq; const float r = rstd_from(ssqv);
        f32x4 g[2][2], v[2][2];
#pragma unroll
        for (int bj = 0; bj < 2; ++bj)
#pragma unroll
            for (int n = 0; n < 2; ++n) { g[bj][n] = *(const f32x4*)(gq + 32 * bj + 16 * n + 4 * fq); v[bj][n] = vin[bj][n] * r; }
        head_norm_rope(v, g, row_pos(row), fq);
#pragma unroll
        for (int bj = 0; bj < 2; ++bj)
#pragma unroll
            for (int n = 0; n < 2; ++n) { const f32x4 x = v[bj][n] * 0.18033688011112042f;   u32x2 w; w.x = cvt_pk_bf16(x[0], x[1]); w.y = cvt_pk_bf16(x[2], x[3]);
                *(u32x2*)(Qb + (size_t)row * DM + colh + 32 * bj + 16 * n) = w; }
    }
    __device__ __forceinline__ const float* ssq_ptr() const { return ssq; }
    PG8_EPI_CALL(false)
};

struct EpiKV {
    static constexpr bool PERM = false, AFTER_DRAIN = false;
    bf16_t* Kb; bf16_t* Vt; const float* ssq; const float* gk; float* ckp; float* cvp; float* cks; float* cvs;
    __device__ __forceinline__ void row(const int row, const f32x4 (&vin)[2][2], int pn, int wc, int fr, int fq, float ssqv) const {
        const int colh = 64 * wc + 4 * fq; const bool isk = (pn == 0); const float r = rstd_from(ssqv);
        f32x4 g[2][2], v[2][2];
#pragma unroll
        for (int bj = 0; bj < 2; ++bj)
#pragma unroll
            for (int n = 0; n < 2; ++n) { g[bj][n] = *(const f32x4*)(gk + 32 * bj + 16 * n + 4 * fq); v[bj][n] = vin[bj][n] * r; }
        if (isk) head_norm_rope(v, g, row_pos(row), fq);
        float* cache = nullptr;
        if (row >= ROWS_PROMPT) cache = (isk ? cks : cvs) + ((size_t)(row - ROWS_PROMPT) * 128 + 127) * 256;
        else { const int t = row & 8191, b = row >> 13; if (t >= 8192 - 128) cache = (isk ? ckp : cvp) + ((size_t)b * 128 + (t - (8192 - 128))) * 256; }
#pragma unroll
        for (int bj = 0; bj < 2; ++bj)
#pragma unroll
            for (int n = 0; n < 2; ++n) {
                const f32x4 x = v[bj][n]; const int c = colh + 32 * bj + 16 * n;
                if (cache) *(f32x4*)(cache + c) = x;
                if (row < ROWS_PROMPT) {
                    if (isk) { u32x2 w; w.x = cvt_pk_bf16(x[0], x[1]); w.y = cvt_pk_bf16(x[2], x[3]); *(u32x2*)(Kb + (size_t)row * 256 + c) = w; }
                    else { const int t = row & 8191, b = row >> 13; const int d = 4 * fq + 32 * bj + 16 * n;
                        bf16_t* vp = Vt + ((size_t)(b * 4 + wc) * 64 + d) * 8192 + t;
                        const unsigned w0 = cvt_pk_bf16(x[0], x[1]), w1 = cvt_pk_bf16(x[2], x[3]);
                        vp[0] = (bf16_t)(w0 & 0xffffu); vp[8192] = (bf16_t)(w0 >> 16); vp[2 * 8192] = (bf16_t)(w1 & 0xffffu); vp[3 * 8192] = (bf16_t)(w1 >> 16); }
                }
            }
    }
    __device__ __forceinline__ const float* ssq_ptr() const { return ssq; }
    PG8_EPI_CALL(false)
};
template <class Epi, class Sched, bool ALIGN_EPI = false, bool SP2 = false>
__device__ __forceinline__ void gemm_phase(const int tid, PG8_LAS unsigned char* lds, const Gemm g, const Sched& S, const Epi& E) {
    const int wid = __builtin_amdgcn_readfirstlane(tid >> 6), lane = tid & 63, wr = wid >> 2, wc = wid & 3, fr = lane & 15, fq = lane >> 4;
    const int K = g.K, nt = K / BK;
    unsigned voffA[2], voffB[2];
#pragma unroll
    for (int i = 0; i < 2; ++i) { int R, C; stage_rc(tid * 16 + i * 8192, R, C); const int Rb = Epi::PERM ? ((R & ~31) + perm32(R & 31)) : R;
        voffA[i] = (unsigned)(R * K + C) * 2u; voffB[i] = (unsigned)(Rb * K + C) * 2u; }
    const size_t kstep = (size_t)(BK * 2);
    const size_t hstep = (size_t)HALF * K * 2;
    const size_t tstep = 2 * hstep;
    const unsigned ldsw = (unsigned)wid * 1024u;
    const int aoff = lds_byte(wr * 64 + fr, fq * 8), boff = lds_byte(wc * 32 + fr, fq * 8);
#define PG8_SA(b, h) (((b) * 2 + (h)) * HTB)
#define PG8_SB(b, h) ((4 + (b) * 2 + (h)) * HTB)
#define PG8_STAGE(bufoff, gbase, voff) do { _Pragma("unroll") for (int _i = 0; _i < 2; ++_i) \
        __builtin_amdgcn_global_load_lds((const unsigned*)((const char*)(gbase) + (voff)[_i]), (PG8_LAS unsigned*)(lds + (bufoff) + ldsw + _i * 8192), 16, 0, 0); } while (0)
#define PG8_LDA(dst, b, h) do { _Pragma("unroll") for (int m = 0; m < 4; ++m) _Pragma("unroll") for (int k = 0; k < 2; ++k) dst[m][k] = *(const PG8_LAS bf16x8*)(lds + PG8_SA(b, h) + aoff + m * 2048 + k * 1024); } while (0)
#define PG8_LDB(dst, b, h) do { _Pragma("unroll") for (int n = 0; n < 2; ++n) _Pragma("unroll") for (int k = 0; k < 2; ++k) dst[n][k] = *(const PG8_LAS bf16x8*)(lds + PG8_SB(b, h) + boff + n * 2048 + k * 1024); } while (0)
#define PG8_MMA(ai, bj, At, Bt) do { __builtin_amdgcn_s_setprio(1); _Pragma("unroll") for (int m = 0; m < 4; ++m) _Pragma("unroll") for (int n = 0; n < 2; ++n) _Pragma("unroll") for (int k = 0; k < 2; ++k) \
        acc[ai][bj][m][n] = __builtin_amdgcn_mfma_f32_16x16x32_bf16(Bt[n][k], At[m][k], acc[ai][bj][m][n], 0, 0, 0); __builtin_amdgcn_s_setprio(0); } while (0)
#define PG8_WAIT_V(n) asm volatile("s_waitcnt vmcnt(" #n ")" ::: "memory")
#define PG8_WAIT_L(n) asm volatile("s_waitcnt lgkmcnt(" #n ")" ::: "memory")
#define PG8_BAR __builtin_amdgcn_s_barrier()
#define PG8_SCHED __builtin_amdgcn_sched_barrier(0)
    Unit cur, nxt; int ui = 0;
    if (!S.next(0, cur)) return;
    typename Epi::Pref pf;
    f32x4 acc[2][2][4][2];
#pragma unroll
    for (int a = 0; a < 2; ++a)
#pragma unroll
        for (int b = 0; b < 2; ++b)
#pragma unroll
            for (int m = 0; m < 4; ++m)
#pragma unroll
                for (int n = 0; n < 2; ++n) acc[a][b][m][n] = (f32x4){0.f, 0.f, 0.f, 0.f};
    bf16x8 At[4][2], B0[2][2], B1[2][2];
    const char* cA = (const char*)g.A + (size_t)cur.pm * tstep; const char* cB = (const char*)g.Bt + (size_t)cur.pn * tstep;
    S.a_ready(cur);
    if constexpr (SP2) {
        PG8_STAGE(PG8_SB(0, 0), cB, voffB); PG8_STAGE(PG8_SB(0, 1), cB + hstep, voffB); PG8_STAGE(PG8_SA(0, 0), cA, voffA); PG8_STAGE(PG8_SA(0, 1), cA + hstep, voffA);
        if (wr == 1) PG8_BAR;
        PG8_WAIT_V(2); PG8_BAR;
        PG8_STAGE(PG8_SB(1, 0), cB + kstep, voffB); PG8_STAGE(PG8_SA(1, 0), cA + kstep, voffA); PG8_STAGE(PG8_SB(1, 1), cB + hstep + kstep, voffB);
        PG8_WAIT_V(6); PG8_BAR;
    } else {
        PG8_STAGE(PG8_SB(0, 0), cB, voffB); PG8_STAGE(PG8_SA(0, 0), cA, voffA); PG8_STAGE(PG8_SB(0, 1), cB + hstep, voffB); PG8_STAGE(PG8_SA(0, 1), cA + hstep, voffA);
        if (wr == 1) PG8_BAR;
        PG8_WAIT_V(4); PG8_BAR;
        PG8_STAGE(PG8_SB(1, 0), cB + kstep, voffB); PG8_STAGE(PG8_SA(1, 0), cA + kstep, voffA); PG8_STAGE(PG8_SB(1, 1), cB + hstep + kstep, voffB);
        PG8_WAIT_V(6); PG8_BAR;
    }
    for (;;) {
        const bool has_next = S.next(ui + 1, nxt);
        const char* nA = has_next ? (const char*)g.A + (size_t)nxt.pm * tstep : cA; const char* nB = has_next ? (const char*)g.Bt + (size_t)nxt.pn * tstep : cB;
        for (int t = 0; t < nt; t += 2) {
            const bool last = (t == nt - 2);
            const char* a1 = cA + (size_t)(t + 1) * kstep;
            const char* a2 = last ? nA : cA + (size_t)(t + 2) * kstep; const char* b2 = last ? nB : cB + (size_t)(t + 2) * kstep;
            const char* a3 = a2 + kstep; const char* b3 = b2 + kstep;
            if (last && has_next) S.a_ready(nxt);
            if constexpr (Epi::PREF) { if (last) E.prefetch(pf, cur, wr, fr); }
            if constexpr (SP2) {
            PG8_LDB(B0, 0, 0); PG8_LDB(B1, 0, 1); PG8_SCHED; PG8_LDA(At, 0, 0); PG8_STAGE(PG8_SA(1, 1), a1 + hstep, voffA);
            PG8_WAIT_V(8); PG8_WAIT_L(0); PG8_BAR; PG8_MMA(0, 0, At, B0); PG8_MMA(0, 1, At, B1); PG8_BAR; PG8_SCHED;
            PG8_LDA(At, 0, 1); PG8_STAGE(PG8_SB(0, 0), b2, voffB); PG8_STAGE(PG8_SB(0, 1), b2 + hstep, voffB); PG8_STAGE(PG8_SA(0, 0), a2, voffA);
            PG8_WAIT_V(8); PG8_WAIT_L(0); PG8_BAR; PG8_MMA(1, 0, At, B0); PG8_MMA(1, 1, At, B1); PG8_BAR; PG8_SCHED;
            PG8_LDB(B0, 1, 0); PG8_LDB(B1, 1, 1); PG8_SCHED; PG8_LDA(At, 1, 0); PG8_STAGE(PG8_SA(0, 1), a2 + hstep, voffA);
            PG8_WAIT_V(8); PG8_WAIT_L(0); PG8_BAR; PG8_MMA(0, 0, At, B0); PG8_MMA(0, 1, At, B1); PG8_BAR; PG8_SCHED;
            PG8_LDA(At, 1, 1); PG8_STAGE(PG8_SB(1, 0), b3, voffB); PG8_STAGE(PG8_SB(1, 1), b3 + hstep, voffB); PG8_STAGE(PG8_SA(1, 0), a3, voffA);
            PG8_WAIT_V(8); PG8_WAIT_L(0); PG8_BAR; PG8_MMA(1, 0, At, B0); PG8_MMA(1, 1, At, B1); PG8_BAR; PG8_SCHED;
            } else {
            PG8_LDB(B0, 0, 0); PG8_SCHED; PG8_LDA(At, 0, 0); PG8_STAGE(PG8_SA(1, 1), a1 + hstep, voffA);
            PG8_WAIT_L(8); PG8_BAR; PG8_WAIT_L(0); PG8_MMA(0, 0, At, B0); PG8_BAR; PG8_SCHED;
            PG8_LDB(B1, 0, 1); PG8_STAGE(PG8_SB(0, 0), b2, voffB);
            PG8_BAR; PG8_WAIT_L(0); PG8_MMA(0, 1, At, B1); PG8_BAR;
            PG8_LDA(At, 0, 1); PG8_STAGE(PG8_SA(0, 0), a2, voffA);
            PG8_BAR; PG8_WAIT_L(0); PG8_MMA(1, 0, At, B0); PG8_BAR; PG8_SCHED;
            PG8_STAGE(PG8_SB(0, 1), b2 + hstep, voffB);
            PG8_WAIT_V(6); PG8_BAR; PG8_MMA(1, 1, At, B1); PG8_BAR;
            PG8_LDB(B0, 1, 0); PG8_SCHED; PG8_LDA(At, 1, 0); PG8_STAGE(PG8_SA(0, 1), a2 + hstep, voffA);
            PG8_WAIT_L(8); PG8_BAR; PG8_WAIT_L(0); PG8_MMA(0, 0, At, B0); PG8_BAR; PG8_SCHED;
            PG8_LDB(B1, 1, 1); PG8_STAGE(PG8_SB(1, 0), b3, voffB);
            PG8_BAR; PG8_WAIT_L(0); PG8_MMA(0, 1, At, B1); PG8_BAR;
            PG8_LDA(At, 1, 1); PG8_STAGE(PG8_SA(1, 0), a3, voffA);
            PG8_BAR; PG8_WAIT_L(0); PG8_MMA(1, 0, At, B0); PG8_BAR; PG8_SCHED;
            PG8_STAGE(PG8_SB(1, 1), b3 + hstep, voffB);
            PG8_WAIT_V(6); PG8_BAR; PG8_MMA(1, 1, At, B1); PG8_BAR;
            }
        }
        if constexpr (ALIGN_EPI) { if (wr == 0) PG8_BAR; }
        if constexpr (!Epi::AFTER_DRAIN) { E(acc, cur, wr, wc, fr, fq, pf); S.done(cur); }
        if (!has_next) break;
#pragma unroll
        for (int a = 0; a < 2; ++a)
#pragma unroll
            for (int b = 0; b < 2; ++b)
#pragma unroll
                for (int m = 0; m < 4; ++m)
#pragma unroll
                    for (int n = 0; n < 2; ++n) acc[a][b][m][n] = (f32x4){0.f, 0.f, 0.f, 0.f};
        cur = nxt; cA = nA; cB = nB; ++ui;
        if constexpr (ALIGN_EPI) { if (wr == 1) PG8_BAR; }
    }
    PG8_WAIT_V(0);
    if constexpr (!ALIGN_EPI) { if (wr == 0) PG8_BAR; }
    PG8_BAR;
    if constexpr (Epi::AFTER_DRAIN) { E.fused(acc, cur, wr, wc, fr, fq, lds, wid, lane); S.done(cur); }
#undef PG8_SA
#undef PG8_SB
#undef PG8_STAGE
#undef PG8_LDA
#undef PG8_LDB
#undef PG8_MMA
#undef PG8_WAIT_V
#undef PG8_WAIT_L
#undef PG8_BAR
#undef PG8_SCHED
}
}
#define LAS __attribute__((address_space(3)))
typedef unsigned short bf16;
typedef float f32x4 __attribute__((ext_vector_type(4)));
typedef unsigned u32x4 __attribute__((ext_vector_type(4)));
typedef unsigned u32x2 __attribute__((ext_vector_type(2)));
typedef short bf16x8 __attribute__((ext_vector_type(8)));
typedef short s16x4 __attribute__((ext_vector_type(4)));
#define LDS_WAIT() asm volatile("s_waitcnt lgkmcnt(0)" ::: "memory")

constexpr int D = 1024, FF = 2816, SEQ = 8192, MP = 16384, NSMP = 128, MR = 16512, MPAD = 16640;
constexpr int NWAVES = 8, NTHREADS = 512, LDS_BYTES = 147456;
#ifndef N_LAUNCH_PER_PHASE
#define N_LAUNCH_PER_PHASE 0
#endif
enum { I_XP = 0, I_XS, I_SCONV, I_CK, I_CV, I_GF1, I_W1G, I_W1U, I_W1D, I_GMIX, I_GF2, I_W2G, I_W2U, I_W2D, I_WINA, I_CONVW, I_WOUTA, I_GKV, I_WKV, I_GKN, I_WQ, I_GQN, I_SINKS, I_WO, N_IN };
constexpr size_t O_YP = 0, O_YS = 16777216, O_CONVP = 16908288, O_KP = 16916480, O_VP = 16982016, O_CONVS = 17047552, O_KS = 17571840, O_VS = 21766144, O_END = 25960448;
constexpr size_t MiB = 1u << 20;
constexpr size_t WS_SSQ = 0;
constexpr size_t SZ_WGU = (size_t)2 * FF * D * 2, SZ_WD = (size_t)D * FF * 2;
constexpr size_t WS_WGU = 1 * MiB;
constexpr size_t WS_WD = WS_WGU + 8 * SZ_WGU;
constexpr size_t WS_WIN = WS_WD + 8 * SZ_WD;
constexpr size_t WS_WOUT = WS_WIN + 2 * (size_t)3 * D * D * 2;
constexpr size_t WS_WKV = WS_WOUT + 2 * (size_t)D * D * 2;
constexpr size_t WS_WQ = WS_WKV + (size_t)512 * D * 2;
constexpr size_t WS_WO = WS_WQ + 2 * (size_t)D * D * 2;
constexpr size_t WS_XB = WS_WO + 2 * (size_t)D * D * 2;
constexpr size_t SZ_ACT = (size_t)MPAD * D * 2;
constexpr size_t WS_H = WS_XB + SZ_ACT;
constexpr size_t WS_KB = WS_H + (size_t)MPAD * FF * 2;
constexpr size_t WS_VT = WS_KB + (size_t)MP * 256 * 2;
constexpr size_t WS_END = WS_VT + (size_t)MP * 256 * 2;
static_assert(2 * SZ_ACT <= (size_t)MPAD * FF * 2, "overlays fit in H");

struct Args { const float* in[N_IN]; float* out; unsigned char* ws; int ph_lo, ph_hi; };
typedef const __attribute__((address_space(4))) Args* ArgsP;

__device__ __forceinline__ unsigned f2bf(float f) { unsigned u = __builtin_bit_cast(unsigned, f); return (u + 0x7fffu + ((u >> 16) & 1u)) >> 16; }
__device__ __forceinline__ unsigned pk2(float lo, float hi) { unsigned r; asm volatile("v_cvt_pk_bf16_f32 %0, %1, %2" : "=v"(r) : "v"(lo), "v"(hi)); return r; }
__device__ __forceinline__ float bf2f(unsigned short b) { return __builtin_bit_cast(float, (unsigned)b << 16); }
__device__ __forceinline__ float bflo(unsigned w) { return __builtin_bit_cast(float, w << 16); }
__device__ __forceinline__ float bfhi(unsigned w) { return __builtin_bit_cast(float, w & 0xffff0000u); }
__device__ __forceinline__ float wave_sum(float v) {
#pragma unroll
    for (int o = 1; o < 64; o <<= 1) v += __shfl_xor(v, o);
    return v;
}
__device__ __forceinline__ float wave_max(float v) {
#pragma unroll
    for (int o = 1; o < 64; o <<= 1) v = fmaxf(v, __shfl_xor(v, o));
    return v;
}

__device__ __forceinline__ int rowmap(int mode, int n) {
    if (mode == 0) return n;
    if (mode == 1) return ((n >> 7) << 8) + (n & 127);
    if (mode == 2) return ((n >> 7) << 8) + 128 + (n & 127);
    if (mode == 3) {
        if (n < 1024) return 2048 + n;
        const int j = (n - 1024) & 1023; return ((j >> 7) << 8) + ((n >= 2048) ? 128 : 0) + (j & 127);
    }
    return (n & ~255) + (((n & 63) >> 5) << 7) + (((n >> 6) & 3) << 5) + (n & 31);
}
struct Job { const float* src; bf16* dst; const float* g; int K, N, mode; };
__device__ __forceinline__ Job get_job(ArgsP a, int j) {
    Job J; unsigned char* ws = a->ws;
    if (j < 24) {
        const int l = j / 6, r = j % 6, f = r / 3, t = r % 3;
        if (t < 2) { J.src = a->in[(f ? I_W2G : I_W1G) + t] + (size_t)l * D * FF; J.K = D; J.N = FF; J.dst = (bf16*)(ws + WS_WGU + (size_t)(2 * l + f) * SZ_WGU);
            J.g = a->in[f ? I_GF2 : I_GF1] + l * D; J.mode = 1 + t; }
        else { J.src = a->in[f ? I_W2D : I_W1D] + (size_t)l * FF * D; J.K = FF; J.N = D; J.dst = (bf16*)(ws + WS_WD + (size_t)(2 * l + f) * SZ_WD); J.g = nullptr; J.mode = 0; }
    } else if (j < 28) {
        const int i = (j - 24) >> 1, t = (j - 24) & 1;
        if (t == 0) { J.src = a->in[I_WINA] + (size_t)i * D * 3 * D; J.K = D; J.N = 3 * D; J.dst = (bf16*)(ws + WS_WIN + (size_t)i * 3 * D * D * 2); J.g = a->in[I_GMIX] + i * D; J.mode = 3; }
        else { J.src = a->in[I_WOUTA] + (size_t)i * D * D; J.K = D; J.N = D; J.dst = (bf16*)(ws + WS_WOUT + (size_t)i * D * D * 2); J.g = nullptr; J.mode = 0; }
    } else if (j == 28) {
        J.src = a->in[I_WKV]; J.K = D; J.N = 512; J.dst = (bf16*)(ws + WS_WKV); J.g = a->in[I_GKV]; J.mode = 4;
    } else {
        const int i = (j - 29) >> 1, t = (j - 29) & 1;
        if (t == 0) { J.src = a->in[I_WQ] + (size_t)i * D * D; J.K = D; J.N = D; J.dst = (bf16*)(ws + WS_WQ + (size_t)i * D * D * 2); J.g = a->in[I_GMIX] + (2 + i) * D; J.mode = 4; }
        else { J.src = a->in[I_WO] + (size_t)i * D * D; J.K = D; J.N = D; J.dst = (bf16*)(ws + WS_WO + (size_t)i * D * D * 2); J.g = nullptr; J.mode = 0; }
    }
    return J;
}
constexpr int NJOBS = 33;
__device__ __forceinline__ void transpose_item(const Job& J, int item, int lane) {
    const int nn = J.N >> 6, kb = item / nn, nb = item - kb * nn, k0 = kb * 32, n = nb * 64 + lane;
    const float* src = J.src + (size_t)k0 * J.N + n;
    float w[32];
#pragma unroll
    for (int j = 0; j < 32; ++j) w[j] = __builtin_nontemporal_load(src + (size_t)j * J.N);
    if (J.g) {
#pragma unroll
        for (int j = 0; j < 32; ++j) w[j] *= J.g[k0 + j];
    }
    bf16* dst = J.dst + (size_t)rowmap(J.mode, n) * J.K + k0;
#pragma unroll
    for (int c = 0; c < 4; ++c) { u32x4 o; o.x = pk2(w[8 * c], w[8 * c + 1]); o.y = pk2(w[8 * c + 2], w[8 * c + 3]); o.z = pk2(w[8 * c + 4], w[8 * c + 5]); o.w = pk2(w[8 * c + 6], w[8 * c + 7]);
        *(u32x4*)(dst + 8 * c) = o; }
}
__device__ __forceinline__ void prologue(ArgsP a, LAS unsigned char* lds, int gw, int ngw, int lane, int wave) {
    int base = 0;
    for (int j = 0; j < NJOBS; ++j) {
        const Job J = get_job(a, j); const int nitems = (J.K / 32) * (J.N / 64);
        int first = gw - (base % ngw); if (first < 0) first += ngw;
        for (int it = first; it < nitems; it += ngw) transpose_item(J, it, lane);
        base += nitems;
    }
    float* X = a->out; bf16* XB = (bf16*)(a->ws + WS_XB); float* ssq = (float*)(a->ws + WS_SSQ);
    for (int m = gw; m < MPAD; m += ngw) {
        u32x2* o8 = (u32x2*)(XB + (size_t)m * D) + lane;
        if (m < MR) {
            const float* src = (m < MP) ? a->in[I_XP] + (size_t)m * D : a->in[I_XS] + (size_t)(m - MP) * D;
            const f32x4* xr = (const f32x4*)src + lane; f32x4* xo = (f32x4*)(X + (size_t)m * D) + lane; float s = 0.f;
#pragma unroll
            for (int j = 0; j < 4; ++j) { const f32x4 v = xr[64 * j]; xo[64 * j] = v; s += (v[0] * v[0] + v[1] * v[1]) + (v[2] * v[2] + v[3] * v[3]);
                u32x2 w; w.x = pk2(v[0], v[1]); w.y = pk2(v[2], v[3]); o8[64 * j] = w; }
            s = wave_sum(s); if (lane == 0) ssq[m] = s;
        } else {
#pragma unroll
            for (int j = 0; j < 4; ++j) o8[64 * j] = (u32x2){0u, 0u};
            if (lane == 0) ssq[m] = 0.f;
        }
    }
    const int gt = gw * 64 + lane, ngt = ngw * 64;
    for (int i = gt; i < 12 * MPAD; i += ngt) ssq[MPAD + i] = 0.f;
    for (int i = gt; i < 2 * NSMP * 127 * 64; i += ngt) {
        const int which = i / (NSMP * 127 * 64), r = i % (NSMP * 127 * 64), b = r / (127 * 64), q = r % (127 * 64), jrow = q >> 6, c4 = q & 63;
        const f32x4 v = *((const f32x4*)(a->in[which ? I_CV : I_CK] + ((size_t)b * 128 + jrow + 1) * 256) + c4);
        *((f32x4*)(a->out + (which ? O_VS : O_KS) + ((size_t)b * 128 + jrow) * 256) + c4) = v;
    }
}

__device__ __forceinline__ void unpack8(const u32x4 w, float (&f)[8]) { f[0] = bflo(w.x); f[1] = bfhi(w.x); f[2] = bflo(w.y); f[3] = bfhi(w.y); f[4] = bflo(w.z); f[5] = bfhi(w.z); f[6] = bflo(w.w); f[7] = bfhi(w.w); }
__device__ __forceinline__ void conv_phase(ArgsP a, int layer, int gt, int ngt) {
    const bf16* CU = (const bf16*)(a->ws + WS_H); bf16* BZ = (bf16*)(a->ws + WS_H + SZ_ACT);
    const float* cw = a->in[I_CONVW] + (size_t)layer * 3 * D; const float* st = a->in[I_SCONV] + (size_t)layer * NSMP * 2 * D;
    float* convp = a->out + O_CONVP + (size_t)layer * 2 * 2 * D; float* convs = a->out + O_CONVS + (size_t)layer * NSMP * 2 * D;
    for (int idx = gt; idx < MR * 128; idx += ngt) {
        const int row = idx >> 7, c8 = (idx & 127) * 8;
        float b[8], c2[8], c1[8], c0[8];
        unpack8(*(const u32x4*)(BZ + (size_t)row * D + c8), b); unpack8(*(const u32x4*)(CU + (size_t)row * D + c8), c2);
        if (row < MP) {
            const int t = row & 8191;
            if (t >= 1) unpack8(*(const u32x4*)(CU + (size_t)(row - 1) * D + c8), c1); else { for (int e = 0; e < 8; ++e) c1[e] = 0.f; }
            if (t >= 2) unpack8(*(const u32x4*)(CU + (size_t)(row - 2) * D + c8), c0); else { for (int e = 0; e < 8; ++e) c0[e] = 0.f; }
            if (t >= 8190) { float* o = convp + ((size_t)(row >> 13) * 2 + (t - 8190)) * D + c8; *(f32x4*)o = (f32x4){c2[0], c2[1], c2[2], c2[3]}; *(f32x4*)(o + 4) = (f32x4){c2[4], c2[5], c2[6], c2[7]}; }
        } else {
            const int bs = row - MP; const float* s0 = st + ((size_t)bs * 2) * D + c8;
            const f32x4 a0 = *(const f32x4*)s0, a1 = *(const f32x4*)(s0 + 4), b0 = *(const f32x4*)(s0 + D), b1 = *(const f32x4*)(s0 + D + 4);
#pragma unroll
            for (int e = 0; e < 4; ++e) { c0[e] = a0[e]; c0[4 + e] = a1[e]; c1[e] = b0[e]; c1[4 + e] = b1[e]; }
            float* o = convs + ((size_t)bs * 2) * D + c8;
            *(f32x4*)o = b0; *(f32x4*)(o + 4) = b1; *(f32x4*)(o + D) = (f32x4){c2[0], c2[1], c2[2], c2[3]}; *(f32x4*)(o + D + 4) = (f32x4){c2[4], c2[5], c2[6], c2[7]};
        }
        const f32x4 w0a = *(const f32x4*)(cw + c8), w0b = *(const f32x4*)(cw + c8 + 4), w1a = *(const f32x4*)(cw + D + c8), w1b = *(const f32x4*)(cw + D + c8 + 4), w2a = *(const f32x4*)(cw + 2 * D + c8), w2b = *(const f32x4*)(cw + 2 * D + c8 + 4);
        float z[8];
#pragma unroll
        for (int e = 0; e < 4; ++e) { z[e] = b[e] * (w0a[e] * c0[e] + w1a[e] * c1[e] + w2a[e] * c2[e]); z[4 + e] = b[4 + e] * (w0b[e] * c0[4 + e] + w1b[e] * c1[4 + e] + w2b[e] * c2[4 + e]); }
        u32x4 w; w.x = pk2(z[0], z[1]); w.y = pk2(z[2], z[3]); w.z = pk2(z[4], z[5]); w.w = pk2(z[6], z[7]);
        *(u32x4*)(BZ + (size_t)row * D + c8) = w;
    }
}

constexpr int KROW = 144, KWIN = 400, VROW = KWIN * 2 + 16, KL_BYTES = KWIN * KROW, VT_OFF = KL_BYTES, VT_BYTES = 64 * VROW, SMP_OFF = 110592;
static_assert(VT_OFF % 16 == 0 && VROW % 16 == 0 && VT_OFF + VT_BYTES <= SMP_OFF && SMP_OFF + 8 * 1024 <= 131072, "attention LDS map");
__device__ __forceinline__ void attn_phase(ArgsP a, int j, LAS unsigned char* lds, int tid, int lane, int wave, int bid, int G) {
    const bf16* Qb = (const bf16*)(a->ws + WS_H); bf16* Ob = (bf16*)(a->ws + WS_H + SZ_ACT);
    const bf16* Kb = (const bf16*)(a->ws + WS_KB); const bf16* Vt = (const bf16*)(a->ws + WS_VT);
    const float* sinks = a->in[I_SINKS] + j * 16;
    const int fr = lane & 15, fq = lane >> 4;
    for (int unit = bid; unit < 256; unit += G) {
        const int b = unit >> 7, kvh = (unit >> 5) & 3, qb2 = unit & 31, t0 = qb2 * 256, tw = t0 - 128;
        const int head = kvh * 4 + (wave >> 1); const float sink = sinks[head] * 1.4426950408889634f;
        const size_t grow0 = (size_t)b * SEQ + t0 + (wave & 1) * 128 + fr;
        const bf16* qp = Qb + grow0 * D + head * 64 + fq * 8;
        bf16x8 nq0 = *(const bf16x8*)qp, nq1 = *(const bf16x8*)(qp + 32);
        __syncthreads();
        for (int c = tid; c < KWIN * 8; c += NTHREADS) { const int row = c >> 3, ch = c & 7, t = tw + row;
            u32x4 v = (u32x4){0u, 0u, 0u, 0u}; if (row < 384 && t >= 0) v = *(const u32x4*)(Kb + ((size_t)b * SEQ + t) * 256 + kvh * 64 + ch * 8);
            *(LAS u32x4*)(lds + row * KROW + ch * 16) = v; }
        for (int c = tid; c < 64 * 50; c += NTHREADS) { const int d = c / 50, ch = c % 50, t = tw + ch * 8;
            u32x4 v = (u32x4){0u, 0u, 0u, 0u}; if (ch < 48 && t >= 0) v = *(const u32x4*)(Vt + ((size_t)(b * 4 + kvh) * 64 + d) * SEQ + t);
            *(LAS u32x4*)(lds + VT_OFF + d * VROW + ch * 16) = v; }
        __syncthreads();
        for (int qt = 0; qt < 8; ++qt) {
            const int q0 = (wave & 1) * 128 + qt * 16, cb = q0 >> 4;
            const bf16x8 qf0 = nq0, qf1 = nq1;
            if (qt < 7) { nq0 = *(const bf16x8*)(qp + (size_t)(qt + 1) * 16 * D); nq1 = *(const bf16x8*)(qp + (size_t)(qt + 1) * 16 * D + 32); }
            f32x4 s[10];
#pragma unroll
            for (int c = 0; c < 9; ++c) {
                const LAS unsigned char* kp = lds + (16 * (cb + c) + fr) * KROW + fq * 16;
                f32x4 acc = (f32x4){0.f, 0.f, 0.f, 0.f};
                acc = __builtin_amdgcn_mfma_f32_16x16x32_bf16(*(const LAS bf16x8*)kp, qf0, acc, 0, 0, 0);
                acc = __builtin_amdgcn_mfma_f32_16x16x32_bf16(*(const LAS bf16x8*)(kp + 64), qf1, acc, 0, 0, 0);
                s[c] = acc;
            }
            float mx = -INFINITY;
#pragma unroll
            for (int i = 0; i < 4; ++i) { s[0][i] = (4 * fq + i >= fr + 1) ? s[0][i] : -INFINITY; s[8][i] = (4 * fq + i <= fr) ? s[8][i] : -INFINITY; }
#pragma unroll
            for (int c = 0; c < 9; ++c) { const bool dead = (qb2 == 0) && (cb + c < 8);
#pragma unroll
                for (int i = 0; i < 4; ++i) { s[c][i] = dead ? -INFINITY : s[c][i]; mx = fmaxf(mx, s[c][i]); } }
            mx = fmaxf(mx, __shfl_xor(mx, 16)); mx = fmaxf(mx, __shfl_xor(mx, 32)); mx = fmaxf(mx, sink);
            float sum = 0.f;
#pragma unroll
            for (int c = 0; c < 9; ++c)
#pragma unroll
                for (int i = 0; i < 4; ++i) { const float p = __builtin_amdgcn_exp2f(s[c][i] - mx); s[c][i] = p; sum += p; }
            s[9] = (f32x4){0.f, 0.f, 0.f, 0.f};
            sum += __shfl_xor(sum, 16); sum += __shfl_xor(sum, 32);
            const float inv = 1.0f / (sum + __builtin_amdgcn_exp2f(sink - mx));
            bf16x8 pb[5];
#pragma unroll
            for (int pp = 0; pp < 5; ++pp) { u32x4 w; w.x = pk2(s[2 * pp][0], s[2 * pp][1]); w.y = pk2(s[2 * pp][2], s[2 * pp][3]); w.z = pk2(s[2 * pp + 1][0], s[2 * pp + 1][1]); w.w = pk2(s[2 * pp + 1][2], s[2 * pp + 1][3]);
                pb[pp] = __builtin_bit_cast(bf16x8, w); }
            bf16* op = Ob + (grow0 + (size_t)qt * 16) * D + head * 64 + 4 * fq;
#pragma unroll
            for (int dt = 0; dt < 4; ++dt) {
                f32x4 o = (f32x4){0.f, 0.f, 0.f, 0.f};
#pragma unroll
                for (int pp = 0; pp < 5; ++pp) {
                    const LAS unsigned char* vp = lds + VT_OFF + (16 * dt + fr) * VROW + (16 * (cb + 2 * pp) + 4 * fq) * 2;
                    const u32x2 lo = *(const LAS u32x2*)vp, hi = *(const LAS u32x2*)(vp + 32);
                    const u32x4 av = (u32x4){lo.x, lo.y, hi.x, hi.y};
                    o = __builtin_amdgcn_mfma_f32_16x16x32_bf16(__builtin_bit_cast(bf16x8, av), pb[pp], o, 0, 0, 0);
                }
                o = o * inv; u32x2 w; w.x = pk2(o[0], o[1]); w.y = pk2(o[2], o[3]);
                *(u32x2*)(op + 16 * dt) = w;
            }
        }
    }
    __syncthreads();
    LAS float* wq = (LAS float*)(lds + SMP_OFF + wave * 1024); LAS float* wsc = wq + 64;
    for (int task = bid * NWAVES + wave; task < NSMP * 16; task += G * NWAVES) {
        const int b = task >> 4, h = task & 15, kvh = h >> 2; const float sink = sinks[h] * 1.4426950408889634f;
        const size_t qoff = (size_t)(MP + b) * D + h * 64;
        wq[lane] = bf2f(Qb[qoff + lane]);
        LDS_WAIT();
        const int sub = lane >> 4, dq = lane & 15;
        const f32x4 q4 = *(const LAS f32x4*)(wq + 4 * dq);
        const float* ks = a->out + O_KS + (size_t)b * 128 * 256 + kvh * 64 + (size_t)sub * 256 + 4 * dq; const float* vs = a->out + O_VS + (size_t)b * 128 * 256 + kvh * 64 + (size_t)sub * 256 + 4 * dq;
        f32x4 kv[32];
#pragma unroll
        for (int it = 0; it < 32; ++it) kv[it] = *(const f32x4*)(ks + (size_t)it * 1024);
#pragma unroll
        for (int it = 0; it < 32; ++it) { const f32x4 k4 = kv[it];
            float p = (q4[0] * k4[0] + q4[1] * k4[1]) + (q4[2] * k4[2] + q4[3] * k4[3]);
            p += __shfl_xor(p, 1); p += __shfl_xor(p, 2); p += __shfl_xor(p, 4); p += __shfl_xor(p, 8);
            if (dq == 0) wsc[it * 4 + sub] = p; }
#pragma unroll
        for (int it = 0; it < 32; ++it) kv[it] = *(const f32x4*)(vs + (size_t)it * 1024);
        LDS_WAIT();
        const float s0 = wsc[lane], s1 = wsc[lane + 64];
        const float mx = fmaxf(wave_max(fmaxf(s0, s1)), sink);
        const float p0 = __builtin_amdgcn_exp2f(s0 - mx), p1 = __builtin_amdgcn_exp2f(s1 - mx);
        const float inv = 1.0f / (wave_sum(p0 + p1) + __builtin_amdgcn_exp2f(sink - mx));
        LDS_WAIT();
        wsc[lane] = p0; wsc[lane + 64] = p1;
        LDS_WAIT();
        f32x4 o4 = (f32x4){0.f, 0.f, 0.f, 0.f};
#pragma unroll
        for (int it = 0; it < 32; ++it) o4 = o4 + kv[it] * wsc[it * 4 + sub];
#pragma unroll
        for (int e = 0; e < 4; ++e) { o4[e] += __shfl_xor(o4[e], 16); o4[e] += __shfl_xor(o4[e], 32); }
        if (sub == 0) { u32x2 w; w.x = pk2(o4[0] * inv, o4[1] * inv); w.y = pk2(o4[2] * inv, o4[3] * inv); *(u32x2*)(Ob + qoff + 4 * dq) = w; }
        LDS_WAIT();
    }
}
#define RLX_AGENT __ATOMIC_RELAXED, __HIP_MEMORY_SCOPE_AGENT
constexpr size_t WS_BAR = 896 * 1024;
constexpr int MISC_OFF = 131072 + 64;
#define XB_TMO      128
#define XB_XCNT(j)  (256  + 64 * (j))
#define XB_XSUB(j)  (1280 + 64 * (j))
#define XB_XGEN(j)  (2304 + 64 * (j))
#define XB_TOP      3328
#define XB_TOPGEN   3392
#define XCD_BAR_WORDS 3456
#define XB_SPIN_CAP (1u << 18)

__device__ __forceinline__ unsigned xb_ld(unsigned* p)              { return __hip_atomic_load(p, __ATOMIC_RELAXED, __HIP_MEMORY_SCOPE_AGENT); }
__device__ __forceinline__ unsigned xb_add(unsigned* p, unsigned v) { return __hip_atomic_fetch_add(p, v, __ATOMIC_RELAXED, __HIP_MEMORY_SCOPE_AGENT); }
__device__ __forceinline__ unsigned xb_xcc_id() { return (unsigned)__builtin_amdgcn_s_getreg((3 << 11) | 20) & 0xFu; }
#define XB_SPIN(cond, bar) do { unsigned _sp = 0; while (cond) { __builtin_amdgcn_s_sleep(1); \
    if ((++_sp & 255u) == 0u) { if (xb_ld(&(bar)[XB_TMO])) break; if (_sp > XB_SPIN_CAP) { atomicAdd(&(bar)[XB_TMO], 1u); break; } } } } while (0)

struct XcdBarrier {
    unsigned* bar; unsigned x;
    volatile LAS unsigned* st;
};

__device__ __forceinline__ XcdBarrier xcd_barrier_post(unsigned* bar, volatile LAS unsigned* st) {
    XcdBarrier b; b.bar = bar; b.x = xb_xcc_id(); b.st = st;
    if (threadIdx.x == 0) (void)xb_add(&bar[XB_XCNT(b.x)], 1u);
    return b;
}
__device__ __forceinline__ void xcd_barrier_complete(unsigned* bar, unsigned x, unsigned& nloc, unsigned& nx) {
    const unsigned G = gridDim.x * gridDim.y * gridDim.z;
    unsigned sum, cnt, mine, sp = 0u;
    for (;;) {
        sum = 0u; cnt = 0u; mine = 0u;
#pragma unroll
        for (unsigned j = 0; j < 16; ++j) { const unsigned c = xb_ld(&bar[XB_XCNT(j)]); sum += c; cnt += (c > 0u) ? 1u : 0u; mine = (j == x) ? c : mine; }
        if (sum == G) break;
        __builtin_amdgcn_s_sleep(1);
        if ((++sp & 255u) == 0u) { if (xb_ld(&bar[XB_TMO])) break; if (sp > XB_SPIN_CAP) { atomicAdd(&bar[XB_TMO], 1u); break; } }
    }
    nloc = mine > 0u ? mine : 1u; nx = cnt > 0u ? cnt : 1u;
}

__device__ __forceinline__ void xcd_barrier(const XcdBarrier& b) {
    asm volatile("s_waitcnt vmcnt(0)" ::: "memory");
    __syncthreads();
    if (threadIdx.x == 0) {
        unsigned* bar = b.bar;
        __builtin_amdgcn_s_waitcnt(0);
        unsigned nloc = b.st[0], nx = b.st[1];
        if (nloc == 0u) { xcd_barrier_complete(bar, b.x, nloc, nx); b.st[0] = nloc; b.st[1] = nx; }
        const unsigned old = xb_add(&bar[XB_XSUB(b.x)], 1u);
        const unsigned gen = old / nloc;
        if (old + 1u == (gen + 1u) * nloc) {
            __builtin_amdgcn_fence(__ATOMIC_RELEASE, "agent");
            asm volatile("s_waitcnt vmcnt(0)" ::: "memory");
            const unsigned og = xb_add(&bar[XB_TOP], 1u);
            const unsigned tg = og / nx;
            if (og + 1u == (tg + 1u) * nx) xb_add(&bar[XB_TOPGEN], 1u);
            else XB_SPIN(xb_ld(&bar[XB_TOPGEN]) == tg, bar);
            __builtin_amdgcn_fence(__ATOMIC_ACQUIRE, "agent");
            xb_add(&bar[XB_XGEN(b.x)], 1u);
            asm volatile("s_waitcnt vmcnt(0)" ::: "memory");
        } else {
            XB_SPIN(xb_ld(&bar[XB_XGEN(b.x)]) == gen, bar);
            __builtin_amdgcn_fence(__ATOMIC_ACQUIRE, "agent");
            asm volatile("s_waitcnt vmcnt(0)" ::: "memory");
        }
    }
    __syncthreads();
}

#ifndef KMASK
#define KMASK 511
#endif
#ifndef DUPMASK
#define DUPMASK 0
#endif
constexpr int NSTEPS = 30;
template <class Epi>
__device__ __forceinline__ void run_gemm(int tid, int bid, int G, LAS unsigned char* lds, const bf16* A, const bf16* Bt, int M, int N, int K, const Epi& E) {
    pg8::Gemm g{A, Bt, M, N, K}; pg8::StaticOrder S; S.init(M, N, G, bid);
    pg8::gemm_phase<Epi, pg8::StaticOrder, true, true>(tid, lds, g, S, E);
}
template <class Epi>
__device__ __forceinline__ void sample_gemm(LAS unsigned char* lds, const bf16* A, const bf16* Bt, int N, int K, const Epi& E, int wg_first, int wg_count, int bid, int wave, int lane) {
    if (bid < wg_first) return;
    const int fr = lane & 15, fq = lane >> 4, ntasks = (N >> 8) * 32, kw = K >> 3;
    LAS float* part = (LAS float*)lds;
    for (int task = bid - wg_first; task < ntasks; task += wg_count) {
        const int rg = task & 7, wc = (task >> 3) & 3, pn = task >> 5;
        const bf16* ap = A + (size_t)(MP + 16 * rg + fr) * K + wave * kw + 8 * fq;
        const bf16* bp[2][2];
#pragma unroll
        for (int bj = 0; bj < 2; ++bj)
#pragma unroll
            for (int n = 0; n < 2; ++n) { const int wrow = pn * 256 + bj * 128 + wc * 32 + (Epi::PERM ? (8 * (fr >> 2) + 4 * n + (fr & 3)) : (16 * n + fr));
                bp[bj][n] = Bt + (size_t)wrow * K + wave * kw + 8 * fq; }
        f32x4 acc[2][2];
#pragma unroll
        for (int bj = 0; bj < 2; ++bj)
#pragma unroll
            for (int n = 0; n < 2; ++n) acc[bj][n] = (f32x4){0.f, 0.f, 0.f, 0.f};
#pragma unroll 4
        for (int k = 0; k < kw; k += 32) {
            const bf16x8 av = *(const bf16x8*)(ap + k);
#pragma unroll
            for (int bj = 0; bj < 2; ++bj)
#pragma unroll
                for (int n = 0; n < 2; ++n) acc[bj][n] = __builtin_amdgcn_mfma_f32_16x16x32_bf16(*(const bf16x8*)(bp[bj][n] + k), av, acc[bj][n], 0, 0, 0);
        }
#pragma unroll
        for (int bj = 0; bj < 2; ++bj)
#pragma unroll
            for (int n = 0; n < 2; ++n)
#pragma unroll
                for (int e = 0; e < 4; ++e) part[(wave * 16 + bj * 8 + n * 4 + e) * 64 + lane] = acc[bj][n][e];
        __syncthreads();
        if (wave == 0) {
            f32x4 v[2][2];
#pragma unroll
            for (int bj = 0; bj < 2; ++bj)
#pragma unroll
                for (int n = 0; n < 2; ++n)
#pragma unroll
                    for (int e = 0; e < 4; ++e) { float sacc = 0.f;
#pragma unroll
                        for (int w = 0; w < 8; ++w) sacc += part[(w * 16 + bj * 8 + n * 4 + e) * 64 + lane];
                        v[bj][n][e] = sacc; }
            E.row(MP + 16 * rg + fr, v, pn, wc, fr, fq, E.ssq_ptr() ? E.ssq_ptr()[MP + 16 * rg + fr] : 0.f);
        }
        __syncthreads();
    }
}
__global__ void __launch_bounds__(NTHREADS, 2) yoco_fwd(Args a) {
    extern __shared__ __attribute__((aligned(16))) unsigned char lds_raw[];
    LAS unsigned char* lds = (LAS unsigned char*)lds_raw;
    cg::grid_group grid = cg::this_grid();
    const int ph_hi = a.ph_hi;
    if (threadIdx.x < 64) ((volatile LAS unsigned*)(lds + 131072))[threadIdx.x] = 0u;
    __syncthreads();
    XcdBarrier bar; bar.bar = (unsigned*)(a.ws + WS_BAR); bar.x = 0; bar.st = (volatile LAS unsigned*)(lds + MISC_OFF);
    if (a.ph_lo > 0) bar = xcd_barrier_post((unsigned*)(a.ws + WS_BAR), (volatile LAS unsigned*)(lds + MISC_OFF));
    int rep = 0; bool posted = a.ph_lo > 0;
    for (int s = a.ph_lo; s < ph_hi; ) {
        ArgsP ap = (ArgsP)__builtin_amdgcn_kernarg_segment_ptr(); asm volatile("" : "+s"(ap));
        int tid = threadIdx.x; asm volatile("" : "+v"(tid));
        int bid = blockIdx.x, G = gridDim.x; asm volatile("" : "+s"(bid), "+s"(G));
        const int lane = tid & 63, wave = __builtin_amdgcn_readfirstlane(tid >> 6);
        const int gw = bid * NWAVES + wave, ngw = G * NWAVES, gt = bid * NTHREADS + tid, ngt = G * NTHREADS;
        unsigned char* ws = ap->ws;
        float* ssq = (float*)(ws + WS_SSQ); float* X = ap->out; bf16* XB = (bf16*)(ws + WS_XB); bf16* H = (bf16*)(ws + WS_H);
        bf16* CUQ = (bf16*)(ws + WS_H); bf16* BZO = (bf16*)(ws + WS_H + SZ_ACT);
        int kind, l = 0, f = 0;
        if (s == 0) kind = 0;
        else if (s == 15) kind = 9;
        else { const int r = (s < 15) ? s - 1 : s - 2; l = r / 7; const int jj = r % 7;
            if (jj == 0) { kind = 1; f = 0; } else if (jj == 1) { kind = 2; f = 0; } else if (jj == 5) { kind = 1; f = 1; } else if (jj == 6) { kind = 2; f = 1; }
            else kind = (l < 2 ? 3 : 6) + (jj - 2); }
        if (kind == 0 && rep == 0) { if (bid == 0) for (int i = tid; i < XCD_BAR_WORDS; i += NTHREADS) __hip_atomic_store((unsigned*)(ws + WS_BAR) + i, 0u, RLX_AGENT); }
        if (kind == 0 && (KMASK & 1)) prologue(ap, lds, gw, ngw, lane, wave);
        else if (kind == 1 && (KMASK & 2)) {
            pg8::EpiSwiGLU E{H, ssq + (size_t)(3 * l + 2 * f) * MPAD};
            const bf16* Bt = (const bf16*)(ws + WS_WGU + (size_t)(2 * l + f) * SZ_WGU);
            run_gemm(tid, bid, G, lds, XB, Bt, MP, 2 * FF, D, E);
            sample_gemm(lds, XB, Bt, 2 * FF, D, E, G / 2, G - G / 2, bid, wave, lane);
        } else if (kind == 2 && (KMASK & 4)) {
            pg8::EpiResid E{X, XB, ssq + (size_t)(3 * l + 2 * f + 1) * MPAD, 0.5f};
            const bf16* Bt = (const bf16*)(ws + WS_WD + (size_t)(2 * l + f) * SZ_WD);
            run_gemm(tid, bid, G, lds, H, Bt, MP, D, FF, E);
            sample_gemm(lds, H, Bt, D, FF, E, 0, G, bid, wave, lane);
        } else if (kind == 3 && (KMASK & 8)) {
            pg8::EpiInProj E{CUQ, BZO, ssq + (size_t)(3 * l + 1) * MPAD};
            const bf16* Bt = (const bf16*)(ws + WS_WIN + (size_t)l * 3 * D * D * 2);
            run_gemm(tid, bid, G, lds, XB, Bt, MP, 3 * D, D, E);
            sample_gemm(lds, XB, Bt, 3 * D, D, E, 0, G, bid, wave, lane);
        } else if (kind == 4 && (KMASK & 16)) conv_phase(ap, l, gt, ngt);
        else if ((kind == 5 || kind == 8) && (KMASK & 32)) {
            pg8::EpiResid E{X, XB, ssq + (size_t)(3 * l + 2) * MPAD, 1.0f};
            const bf16* Bt = (kind == 5) ? (const bf16*)(ws + WS_WOUT + (size_t)l * D * D * 2) : (const bf16*)(ws + WS_WO + (size_t)(l - 2) * D * D * 2);
            run_gemm(tid, bid, G, lds, BZO, Bt, MP, D, D, E);
            sample_gemm(lds, BZO, Bt, D, D, E, 0, G, bid, wave, lane);
        } else if (kind == 6 && (KMASK & 64)) {
            pg8::EpiQ E{CUQ, ssq + (size_t)(3 * l + 1) * MPAD, ap->in[I_GQN] + (l - 2) * 64};
            const bf16* Bt = (const bf16*)(ws + WS_WQ + (size_t)(l - 2) * D * D * 2);
            run_gemm(tid, bid, G, lds, XB, Bt, MP, D, D, E);
            sample_gemm(lds, XB, Bt, D, D, E, 0, G, bid, wave, lane);
        } else if (kind == 7 && (KMASK & 128)) attn_phase(ap, l - 2, lds, tid, lane, wave, bid, G);
        else if (kind == 9 && (KMASK & 256)) {
            pg8::EpiKV E{(bf16*)(ws + WS_KB), (bf16*)(ws + WS_VT), ssq + (size_t)6 * MPAD, ap->in[I_GKN], ap->out + O_KP, ap->out + O_VP, ap->out + O_KS, ap->out + O_VS};
            run_gemm(tid, bid, G, lds, XB, (const bf16*)(ws + WS_WKV), MP, 512, D, E);
            sample_gemm(lds, XB, (const bf16*)(ws + WS_WKV), 512, D, E, G / 2, G - G / 2, bid, wave, lane);
        }
        const bool again = ((DUPMASK >> kind) & 1) && rep == 0;
        if (again || s + 1 < ph_hi) {
            if (!posted) { grid.sync(); bar = xcd_barrier_post((unsigned*)(ws + WS_BAR), (volatile LAS unsigned*)(lds + MISC_OFF)); posted = true; }
            else xcd_barrier(bar);
        }
        if (again) rep = 1; else { rep = 0; ++s; }
    }
}

extern "C" void kernel_launch(void* const* d_in, const int* in_sizes, int n_in, void* d_out, int out_size, void* d_ws, size_t ws_size, hipStream_t stream) {
    static int grid = 0;
    if (grid == 0) {
        if (n_in != N_IN || (size_t)out_size != O_END || ws_size < WS_END) { fprintf(stderr, "kernel_launch: unexpected shapes: n_in %d out %d ws %zu (need %zu)\n", n_in, out_size, ws_size, (size_t)WS_END); grid = -1; return; }
        int dev = 0, cus = 0, per_cu = 0;
        hipGetDevice(&dev); hipDeviceGetAttribute(&cus, hipDeviceAttributeMultiprocessorCount, dev);
        if (hipFuncSetAttribute((const void*)yoco_fwd, hipFuncAttributeMaxDynamicSharedMemorySize, LDS_BYTES) != hipSuccess) { fprintf(stderr, "kernel_launch: hipFuncSetAttribute failed\n"); grid = -1; return; }
        if (hipOccupancyMaxActiveBlocksPerMultiprocessor(&per_cu, (const void*)yoco_fwd, NTHREADS, LDS_BYTES) != hipSuccess || per_cu < 1) { fprintf(stderr, "kernel_launch: occupancy query says %d\n", per_cu); per_cu = 1; }
        (void)hipGetLastError();
        grid = cus * 1;
    }
    if (grid < 0) return;
    Args a{};
    for (int i = 0; i < N_IN; ++i) a.in[i] = (const float*)d_in[i];
    a.out = (float*)d_out; a.ws = (unsigned char*)d_ws;
#if N_LAUNCH_PER_PHASE
    for (int s = 0; s < NSTEPS; ++s) { a.ph_lo = s; a.ph_hi = s + 1; hipLaunchKernelGGL(yoco_fwd, dim3(grid), dim3(NTHREADS), LDS_BYTES, stream, a); }
#else
    a.ph_lo = 0; a.ph_hi = NSTEPS;
    void* args[] = {&a};
    hipError_t e = hipLaunchCooperativeKernel((const void*)yoco_fwd, dim3(grid), dim3(NTHREADS), args, LDS_BYTES, stream);
    if (e != hipSuccess) fprintf(stderr, "kernel_launch: cooperative launch failed: %s (grid %d)\n", hipGetErrorString(e), grid);
#endif
}
```
